# Optimizing an MI355X kernel written in HIP

```python
import jax, jax.numpy as jnp
from jax import lax
import numpy as np

D_MODEL = 1024
BATCH = 1
SEQ = 16384
DEPTH = 1

HEAD_DIM = 64
ATTN_WIDTH = D_MODEL // 2
N_HEADS = ATTN_WIDTH // HEAD_DIM
N_KV_HEADS = 2
KV_GROUP = N_HEADS // N_KV_HEADS
KV_WIDTH = N_KV_HEADS * HEAD_DIM
WINDOW = 128
ATTN_BLOCK = 128
ROPE_THETA = 10000.0
NEG_INF = -1e30
LRU_WIDTH = D_MODEL - ATTN_WIDTH
LRU_BLOCKS = 8
LRU_BLOCK_DIM = LRU_WIDTH // LRU_BLOCKS
CONV_WIDTH = 4
LRU_C = 8.0
MIX_WIDTH = ATTN_WIDTH + LRU_WIDTH
IN_WIDTH = ATTN_WIDTH + 2 * KV_WIDTH + 2 * LRU_WIDTH
N_EXPERTS = 64
TOP_K = 8
N_GROUPS = 8
TOPK_GROUPS = 4
D_EXPERT = D_MODEL // 4
ROUTED_SCALE = 2.5
MOE_BLOCK = 128
ALPHA = (2.0 * DEPTH) ** 0.25
BETA = (8.0 * DEPTH) ** -0.25
NORM_EPS = 1e-5

kernel_name = "hymba_swa_rglru_moe_deepnorm"


def _layernorm(z, g, b):
    z32 = z.astype(jnp.float32)
    mu = z32.mean(-1, keepdims=True)
    var = jnp.square(z32 - mu).mean(-1, keepdims=True)
    out = (z32 - mu) * lax.rsqrt(var + NORM_EPS) * g.astype(jnp.float32) + b.astype(jnp.float32)
    return out.astype(z.dtype)


def _rmsnorm(z, g):
    z32 = z.astype(jnp.float32)
    return z32 * lax.rsqrt(jnp.square(z32).mean(-1, keepdims=True) + NORM_EPS) * g.astype(jnp.float32)


def _rope_tables(seq):
    pos = jnp.arange(seq, dtype=jnp.float32)
    inv_freq = ROPE_THETA ** (-jnp.arange(0, HEAD_DIM, 2, dtype=jnp.float32) / HEAD_DIM)
    ang = pos[:, None] * inv_freq[None, :]
    return jnp.cos(ang), jnp.sin(ang)


def _rope(t, cos, sin):
    t32 = t.astype(jnp.float32)
    t1, t2 = jnp.split(t32, 2, axis=-1)
    c = cos[None, :, None, :]
    s = sin[None, :, None, :]
    return jnp.concatenate([t1 * c - t2 * s, t2 * c + t1 * s], axis=-1)


def _sliding_window_attention(q, k, v, sinks):
    bsz, seq = q.shape[0], q.shape[1]
    nb = seq // ATTN_BLOCK
    qb = q.reshape(bsz, nb, ATTN_BLOCK, N_KV_HEADS, KV_GROUP, HEAD_DIM)

    def band(t):
        tp = jnp.pad(t.astype(jnp.float32), ((0, 0), (ATTN_BLOCK, 0), (0, 0), (0, 0)))
        tp = tp.reshape(bsz, nb + 1, ATTN_BLOCK, N_KV_HEADS, HEAD_DIM)
        return jnp.concatenate([tp[:, :-1], tp[:, 1:]], axis=2)

    kb, vb = band(k), band(v)
    logits = jnp.einsum('bnqhgd,bnkhd->bnhgqk', qb, kb) * (HEAD_DIM ** -0.5)
    blk = jnp.arange(nb)[:, None]
    qpos = blk * ATTN_BLOCK + jnp.arange(ATTN_BLOCK)[None, :]
    kpos = (blk - 1) * ATTN_BLOCK + jnp.arange(2 * ATTN_BLOCK)[None, :]
    diff = qpos[:, :, None] - kpos[:, None, :]
    allowed = (diff >= 0) & (diff < WINDOW) & (kpos[:, None, :] >= 0)
    logits = jnp.where(allowed[None, :, None, None], logits, NEG_INF)
    sink = sinks.astype(jnp.float32).reshape(1, 1, N_KV_HEADS, KV_GROUP, 1, 1)
    m = jnp.maximum(logits.max(-1, keepdims=True), sink)
    p = jnp.exp(logits - m)
    denom = p.sum(-1, keepdims=True) + jnp.exp(sink - m)
    out = jnp.einsum('bnhgqk,bnkhd->bnqhgd', p / denom, vb)
    return out.reshape(bsz, seq, ATTN_WIDTH)


def _causal_depthwise_conv(xr, conv_w, conv_b):
    out = lax.conv_general_dilated(
        xr, conv_w[:, None, :], window_strides=(1,), padding=[(CONV_WIDTH - 1, 0)],
        dimension_numbers=('NWC', 'WIO', 'NWC'), feature_group_count=LRU_WIDTH)
    return out + conv_b


def _rg_lru(xr, w_rg, b_rg, w_ig, b_ig, lam):
    bsz, seq = xr.shape[0], xr.shape[1]
    xb = xr.reshape(bsz, seq, LRU_BLOCKS, LRU_BLOCK_DIM)
    r = jax.nn.sigmoid(jnp.einsum('bsni,nij->bsnj', xb, w_rg).reshape(bsz, seq, LRU_WIDTH) + b_rg)
    i = jax.nn.sigmoid(jnp.einsum('bsni,nij->bsnj', xb, w_ig).reshape(bsz, seq, LRU_WIDTH) + b_ig)
    log_a = -LRU_C * r * jax.nn.softplus(-lam)
    a = jnp.exp(log_a)
    inp = jnp.sqrt(-jnp.expm1(2.0 * log_a)) * (i * xr)

    def combine(left, right):
        a1, b1 = left
        a2, b2 = right
        return a1 * a2, a2 * b1 + b2

    _, h = lax.associative_scan(combine, (a, inp), axis=1)
    return h


def _hybrid_mixer(x, w_in, conv_w, conv_b, w_rg, b_rg, w_ig, b_ig, lam, sinks, g_attn, g_lru, w_out, cos, sin):
    bsz, seq, _ = x.shape
    f32 = jnp.float32
    u = x @ w_in
    q, k, v, xr, yg = jnp.split(
        u, [ATTN_WIDTH, ATTN_WIDTH + KV_WIDTH, ATTN_WIDTH + 2 * KV_WIDTH,
            ATTN_WIDTH + 2 * KV_WIDTH + LRU_WIDTH], axis=-1)
    q = _rope(q.reshape(bsz, seq, N_HEADS, HEAD_DIM), cos, sin)
    k = _rope(k.reshape(bsz, seq, N_KV_HEADS, HEAD_DIM), cos, sin)
    v = v.reshape(bsz, seq, N_KV_HEADS, HEAD_DIM)
    attn = _sliding_window_attention(q, k, v, sinks)
    xc = _causal_depthwise_conv(xr.astype(f32), conv_w.astype(f32), conv_b.astype(f32))
    hr = _rg_lru(xc, w_rg.astype(f32), b_rg.astype(f32), w_ig.astype(f32), b_ig.astype(f32), lam.astype(f32))
    lru = jax.nn.gelu(yg.astype(f32)) * hr
    mixed = jnp.concatenate([_rmsnorm(attn, g_attn), _rmsnorm(lru, g_lru)], axis=-1).astype(x.dtype)
    return mixed @ w_out


def _moe(h, w_router, e_bias, w_gate, w_up, w_down, ws_gate, ws_up, ws_down):
    bsz, seq, dm = h.shape
    f32 = jnp.float32
    n_tok = bsz * seq
    hf = h.reshape(n_tok, dm)
    scores = jax.nn.sigmoid(hf.astype(f32) @ w_router.astype(f32))
    sel = scores + e_bias.astype(f32)
    grp = sel.reshape(n_tok, N_GROUPS, N_EXPERTS // N_GROUPS)
    group_score = lax.top_k(grp, 2)[0].sum(-1)
    gidx = lax.top_k(group_score, TOPK_GROUPS)[1]
    gmask = jax.nn.one_hot(gidx, N_GROUPS, dtype=f32).sum(1) > 0
    emask = jnp.repeat(gmask, N_EXPERTS // N_GROUPS, axis=-1)
    _, idx = lax.top_k(jnp.where(emask, sel, -jnp.inf), TOP_K)
    wts = jnp.take_along_axis(scores, idx, axis=-1)
    wts = wts / wts.sum(-1, keepdims=True) * ROUTED_SCALE
    n_pairs = n_tok * TOP_K
    n_rows = (-(-n_pairs // MOE_BLOCK)) * MOE_BLOCK + N_EXPERTS * MOE_BLOCK
    n_blocks = n_rows // MOE_BLOCK
    flat_e = idx.reshape(-1).astype(jnp.int32)
    flat_tok = jnp.arange(n_pairs, dtype=jnp.int32) // TOP_K
    flat_w = wts.reshape(-1)
    order = jnp.argsort(flat_e, stable=True)
    sorted_e = flat_e[order]
    counts = jnp.bincount(flat_e, length=N_EXPERTS)
    padded = (counts + MOE_BLOCK - 1) // MOE_BLOCK * MOE_BLOCK
    pad_end = jnp.cumsum(padded)
    pad_start = pad_end - padded
    sort_start = jnp.cumsum(counts) - counts
    dest = pad_start[sorted_e] + (jnp.arange(n_pairs, dtype=jnp.int32) - sort_start[sorted_e])
    row_token = jnp.full((n_rows,), n_tok, jnp.int32).at[dest].set(flat_tok[order])
    row_weight = jnp.zeros((n_rows,), f32).at[dest].set(flat_w[order])
    block_expert = jnp.minimum(
        jnp.searchsorted(pad_end, jnp.arange(n_blocks) * MOE_BLOCK, side='right'), N_EXPERTS - 1)
    hp = jnp.concatenate([hf, jnp.zeros((1, dm), hf.dtype)], axis=0)

    def body(acc, blk):
        toks, bw, e = blk
        xb = hp[toks]
        yb = (jax.nn.silu(xb @ w_gate[e]) * (xb @ w_up[e])) @ w_down[e]
        return acc.at[toks].add(yb.astype(f32) * bw[:, None]), None

    acc0 = jnp.zeros((n_tok + 1, dm), f32)
    acc, _ = lax.scan(body, acc0, (row_token.reshape(n_blocks, MOE_BLOCK),
                                   row_weight.reshape(n_blocks, MOE_BLOCK), block_expert))
    shared = (jax.nn.silu(hf @ ws_gate) * (hf @ ws_up)) @ ws_down
    return (acc[:n_tok] + shared.astype(f32)).astype(h.dtype).reshape(bsz, seq, dm)


def setup_inputs(seed: int = 0) -> dict:
    key = jax.random.key(seed)
    ks = jax.random.split(key, 32)
    L = DEPTH
    f32 = jnp.float32

    def nrm(k, shape, scale):
        return jax.random.normal(k, shape, f32) * scale

    u = jax.random.uniform(ks[8], (L, LRU_WIDTH), f32, minval=0.9, maxval=0.999)
    s = u ** (1.0 / LRU_C)
    lam = jnp.log(s) - jnp.log1p(-s)
    return {
        "x": nrm(ks[0], (BATCH, SEQ, D_MODEL), 1.0),
        "w_in": nrm(ks[1], (L, D_MODEL, IN_WIDTH), D_MODEL ** -0.5),
        "conv_w": nrm(ks[2], (L, CONV_WIDTH, LRU_WIDTH), CONV_WIDTH ** -0.5),
        "conv_b": nrm(ks[3], (L, LRU_WIDTH), 0.02),
        "w_rg": nrm(ks[4], (L, LRU_BLOCKS, LRU_BLOCK_DIM, LRU_BLOCK_DIM), LRU_BLOCK_DIM ** -0.5),
        "b_rg": nrm(ks[5], (L, LRU_WIDTH), 0.02),
        "w_ig": nrm(ks[6], (L, LRU_BLOCKS, LRU_BLOCK_DIM, LRU_BLOCK_DIM), LRU_BLOCK_DIM ** -0.5),
        "b_ig": nrm(ks[7], (L, LRU_WIDTH), 0.02),
        "lam": lam,
        "sinks": nrm(ks[9], (L, N_HEADS), 0.5),
        "g_attn": 1.0 + nrm(ks[10], (L, ATTN_WIDTH), 0.02),
        "g_lru": 1.0 + nrm(ks[11], (L, LRU_WIDTH), 0.02),
        "w_out": nrm(ks[12], (L, MIX_WIDTH, D_MODEL), MIX_WIDTH ** -0.5 * BETA),
        "ln1_g": 1.0 + nrm(ks[13], (L, D_MODEL), 0.02),
        "ln1_b": nrm(ks[14], (L, D_MODEL), 0.02),
        "w_router": nrm(ks[15], (L, D_MODEL, N_EXPERTS), D_MODEL ** -0.5),
        "e_bias": nrm(ks[16], (L, N_EXPERTS), 0.01),
        "w_gate": nrm(ks[17], (L, N_EXPERTS, D_MODEL, D_EXPERT), D_MODEL ** -0.5),
        "w_up": nrm(ks[18], (L, N_EXPERTS, D_MODEL, D_EXPERT), D_MODEL ** -0.5),
        "w_down": nrm(ks[19], (L, N_EXPERTS, D_EXPERT, D_MODEL), D_EXPERT ** -0.5 * BETA),
        "ws_gate": nrm(ks[20], (L, D_MODEL, D_EXPERT), D_MODEL ** -0.5),
        "ws_up": nrm(ks[21], (L, D_MODEL, D_EXPERT), D_MODEL ** -0.5),
        "ws_down": nrm(ks[22], (L, D_EXPERT, D_MODEL), D_EXPERT ** -0.5 * BETA),
        "ln2_g": 1.0 + nrm(ks[23], (L, D_MODEL), 0.02),
        "ln2_b": nrm(ks[24], (L, D_MODEL), 0.02),
    }


def reference(x, w_in, conv_w, conv_b, w_rg, b_rg, w_ig, b_ig, lam, sinks, g_attn, g_lru, w_out,
              ln1_g, ln1_b, w_router, e_bias, w_gate, w_up, w_down, ws_gate, ws_up, ws_down, ln2_g, ln2_b):
    cos, sin = _rope_tables(x.shape[1])
    h = x
    for l in range(DEPTH):
        mix = _hybrid_mixer(h, w_in[l], conv_w[l], conv_b[l], w_rg[l], b_rg[l], w_ig[l], b_ig[l],
                            lam[l], sinks[l], g_attn[l], g_lru[l], w_out[l], cos, sin)
        h = _layernorm(ALPHA * h + mix, ln1_g[l], ln1_b[l])
        ffn = _moe(h, w_router[l], e_bias[l], w_gate[l], w_up[l], w_down[l], ws_gate[l], ws_up[l], ws_down[l])
        h = _layernorm(ALPHA * h + ffn, ln2_g[l], ln2_b[l])
    return h
```

```cpp
#include <hip/hip_runtime.h>
#include <cstdio>
#include <cstdint>

#ifndef MK_N_LAUNCHES
#define MK_N_LAUNCHES 9
#endif
#ifndef GEMM_REF
#define GEMM_REF 0
#endif

#define LAS __attribute__((address_space(3)))
#define GAS __attribute__((address_space(1)))
typedef unsigned short bf16;
typedef unsigned v4u __attribute__((ext_vector_type(4)));
typedef unsigned v2u __attribute__((ext_vector_type(2)));
typedef float f32x4 __attribute__((ext_vector_type(4)));
typedef float f32x2 __attribute__((ext_vector_type(2)));
typedef short bf16x8 __attribute__((ext_vector_type(8)));

constexpr int S = 16384, D = 1024, NIN = 1792, AW = 512, KVW = 128, LW = 512, NE = 64, NEX = 65, DE = 256, TOPK = 8;
constexpr int LCAP = 16384;
constexpr float ALPHA = 1.18920711500272f;
constexpr float NORM_EPS = 1e-5f;
constexpr int NWAVES = 8;
constexpr int NPHASE = 9;

constexpr size_t MiB = 1u << 20;
constexpr size_t WS_CTL = 0, CTL_ZERO_BYTES = 1 * MiB;
constexpr size_t WS_ROPEC = 1 * MiB, WS_ROPES = 3 * MiB;
constexpr size_t WS_AGG = 5 * MiB;
constexpr size_t WS_RIE = 6 * MiB;
constexpr size_t WS_RIW = 6 * MiB + 512 * 1024;
constexpr size_t WS_TOK = 7 * MiB;
constexpr size_t WS_WIN = 17 * MiB;
constexpr size_t WS_WOUT = 21 * MiB;
constexpr size_t WS_WD = 23 * MiB;
constexpr size_t WS_A2 = 56 * MiB;
constexpr size_t WS_WGU = 136 * MiB;
constexpr size_t WS_A1 = 201 * MiB;
constexpr size_t WS_Y8 = 136 * MiB;
constexpr size_t WS_END = 264 * MiB;
constexpr size_t U_Q = 0, U_K = 16 * MiB, U_V = 20 * MiB, U_XR = 24 * MiB, U_YG = 40 * MiB;
constexpr int CW_BAR = 4096;
constexpr int CW_CNT = 16384;

constexpr int RING_BYTES = 131072;
constexpr int SCR_OFF = RING_BYTES, SCR_BYTES = 20480;
constexpr int MISC_OFF = SCR_OFF + SCR_BYTES;
constexpr int LDS_BYTES = MISC_OFF + 512;

__device__ __forceinline__ float bf2f(unsigned b) { return __uint_as_float(b << 16); }
__device__ __forceinline__ unsigned f2bf(float f) { unsigned u = __float_as_uint(f); return (u + 0x7fffu + ((u >> 16) & 1u)) >> 16; }
__device__ __forceinline__ unsigned pk2(float lo, float hi) { return f2bf(lo) | (f2bf(hi) << 16); }
__device__ __forceinline__ float fast_exp(float x) { return __builtin_amdgcn_exp2f(x * 1.44269504089f); }
__device__ __forceinline__ float sigmoidf_(float x) { return 1.0f / (1.0f + fast_exp(-x)); }

namespace pg8 {
constexpr int BM = 256, BK = 64, HALF = 128, HTB = HALF * BK * 2, STAGE_BYTES = 8 * HTB, NXCD = 8, WGM = 8;
__host__ __device__ __forceinline__ int lds_byte(int r, int c) { const int st = (r >> 4) * 2 + (c >> 5), rr = r & 15, cc = c & 31, ob = rr * 64 + cc * 2; return st * 1024 + (ob ^ (((ob >> 9) & 1) << 5)); }
__host__ __device__ __forceinline__ void stage_rc(int b, int& R, int& C) { const int st = b / 1024, sb = b % 1024, swz = sb ^ (((sb >> 9) & 1) << 5); R = (st >> 1) * 16 + swz / 64; C = (st & 1) * 32 + (swz % 64) / 2; }
__host__ __device__ __forceinline__ int perm32(int rho) { const int n = rho >> 4, i = rho & 15; return 8 * (i >> 2) + 4 * n + (i & 3); }

struct Unit { const char* B; int row0; int slot0; int pn; int e; int cnt; int y0; };

__device__ __forceinline__ unsigned cvt_pk_bf16(float lo, float hi) { unsigned r; asm volatile("v_cvt_pk_bf16_f32 %0, %1, %2" : "=v"(r) : "v"(lo), "v"(hi)); return r; }

#if GEMM_REF
template <class Epi, class Sched, bool ALIGN_EPI>
__device__ __forceinline__ void gemm_phase(LAS unsigned char* lds, const char* Abase, const int K, const Sched& S, const Epi& E) {
    const int tid = threadIdx.x, wid = __builtin_amdgcn_readfirstlane(tid >> 6), lane = tid & 63, wr = wid >> 2, wc = wid & 3, fr = lane & 15, fq = lane >> 4;
    Unit cur;
    for (int ui = 0; S.next(ui, cur); ++ui) {
        f32x4 acc[2][2][4][2];
#pragma unroll
        for (int ai = 0; ai < 2; ++ai)
#pragma unroll
            for (int bj = 0; bj < 2; ++bj)
#pragma unroll
                for (int m = 0; m < 4; ++m)
#pragma unroll
                    for (int n = 0; n < 2; ++n)
#pragma unroll
                        for (int j = 0; j < 4; ++j) {
                            const int row = ai * 128 + wr * 64 + m * 16 + fr;
                            const int col = bj * 128 + wc * 32 + (Epi::PERM ? (8 * fq + 4 * n + j) : (16 * n + 4 * fq + j));
                            const bf16* a = (const bf16*)(Abase + S.aoff(cur, row)); const bf16* b = (const bf16*)(cur.B) + (size_t)col * K;
                            float s = 0.f;
                            for (int k = 0; k < K; k += 8) { const v4u av = *(const v4u*)(a + k), bv = *(const v4u*)(b + k);
#pragma unroll
                                for (int q = 0; q < 4; ++q) { s += bf2f(av[q] & 0xffffu) * bf2f(bv[q] & 0xffffu); s += bf2f(av[q] >> 16) * bf2f(bv[q] >> 16); } }
                            acc[ai][bj][m][n][j] = s;
                        }
        E(acc, cur, wr, wc, fr, fq);
    }
    __syncthreads();
}
#else
template <class Epi, class Sched, bool ALIGN_EPI>
__device__ __forceinline__ void gemm_phase(LAS unsigned char* lds, const char* Abase, const int K_, const Sched& S, const Epi& E) {
    const int tid = threadIdx.x, wid = __builtin_amdgcn_readfirstlane(tid >> 6), lane = tid & 63, wr = wid >> 2, wc = wid & 3, fr = lane & 15, fq = lane >> 4;
    int K = K_; asm volatile("" : "+s"(K));
    const int nt = K / BK;
    int RA[2]; unsigned CA2[2], voffB[2];
#pragma unroll
    for (int i = 0; i < 2; ++i) { int R, C; stage_rc(tid * 16 + i * 8192, R, C); const int Rb = Epi::PERM ? ((R & ~31) + perm32(R & 31)) : R;
        RA[i] = R; CA2[i] = (unsigned)C * 2u; voffB[i] = (unsigned)(Rb * K + C) * 2u; }
    const size_t kstep = (size_t)(BK * 2);
    const size_t hstep = (size_t)HALF * K * 2;
    const unsigned ldsw = (unsigned)wid * 1024u;
    const int aoff = lds_byte(wr * 64 + fr, fq * 8), boff = lds_byte(wc * 32 + fr, fq * 8);
#define PG8_SA(b, h) (((b) * 2 + (h)) * HTB)
#define PG8_SB(b, h) ((4 + (b) * 2 + (h)) * HTB)
#define PG8_STAGE(bufoff, gbase, voff) do { _Pragma("unroll") for (int _i = 0; _i < 2; ++_i) \
        __builtin_amdgcn_global_load_lds((const unsigned*)((const char*)(gbase) + (voff)[_i]), (LAS unsigned*)(lds + (bufoff) + ldsw + _i * 8192), 16, 0, 0); } while (0)
#define PG8_LDA(dst, b, h) do { _Pragma("unroll") for (int m = 0; m < 4; ++m) _Pragma("unroll") for (int k = 0; k < 2; ++k) dst[m][k] = *(const LAS bf16x8*)(lds + PG8_SA(b, h) + aoff + m * 2048 + k * 1024); } while (0)
#define PG8_LDB(dst, b, h) do { _Pragma("unroll") for (int n = 0; n < 2; ++n) _Pragma("unroll") for (int k = 0; k < 2; ++k) dst[n][k] = *(const LAS bf16x8*)(lds + PG8_SB(b, h) + boff + n * 2048 + k * 1024); } while (0)
#define PG8_MMA(ai, bj, At, Bt) do { __builtin_amdgcn_s_setprio(1); _Pragma("unroll") for (int m = 0; m < 4; ++m) _Pragma("unroll") for (int n = 0; n < 2; ++n) _Pragma("unroll") for (int k = 0; k < 2; ++k) \
        acc[ai][bj][m][n] = __builtin_amdgcn_mfma_f32_16x16x32_bf16(Bt[n][k], At[m][k], acc[ai][bj][m][n], 0, 0, 0); __builtin_amdgcn_s_setprio(0); } while (0)
#define PG8_WAIT_V(n) asm volatile("s_waitcnt vmcnt(" #n ")" ::: "memory")
#define PG8_WAIT_L(n) asm volatile("s_waitcnt lgkmcnt(" #n ")" ::: "memory")
#define PG8_BAR __builtin_amdgcn_s_barrier()
#define PG8_SCHED __builtin_amdgcn_sched_barrier(0)
    Unit cur, nxt; int ui = 0;
    if (!S.next(0, cur)) return;
    unsigned curA[2][2], nxtA[2][2];
#pragma unroll
    for (int h = 0; h < 2; ++h)
#pragma unroll
        for (int i = 0; i < 2; ++i) curA[h][i] = S.aoff(cur, h * HALF + RA[i]) + CA2[i];
    f32x4 acc[2][2][4][2];
#pragma unroll
    for (int a = 0; a < 2; ++a)
#pragma unroll
        for (int b = 0; b < 2; ++b)
#pragma unroll
            for (int m = 0; m < 4; ++m)
#pragma unroll
                for (int n = 0; n < 2; ++n) acc[a][b][m][n] = (f32x4){0.f, 0.f, 0.f, 0.f};
    bf16x8 At[4][2], B0[2][2], B1[2][2];
    const char* cB = cur.B;
    PG8_STAGE(PG8_SB(0, 0), cB, voffB); PG8_STAGE(PG8_SB(0, 1), cB + hstep, voffB); PG8_STAGE(PG8_SA(0, 0), Abase, curA[0]); PG8_STAGE(PG8_SA(0, 1), Abase, curA[1]);
    if (wr == 1) PG8_BAR;
    PG8_WAIT_V(2); PG8_BAR;
    PG8_STAGE(PG8_SB(1, 0), cB + kstep, voffB); PG8_STAGE(PG8_SA(1, 0), Abase + kstep, curA[0]); PG8_STAGE(PG8_SB(1, 1), cB + hstep + kstep, voffB);
    PG8_WAIT_V(6); PG8_BAR;
    for (;;) {
        const bool has_next = S.next(ui + 1, nxt);
#pragma unroll
        for (int h = 0; h < 2; ++h)
#pragma unroll
            for (int i = 0; i < 2; ++i) nxtA[h][i] = has_next ? (S.aoff(nxt, h * HALF + RA[i]) + CA2[i]) : curA[h][i];
        const char* nB = has_next ? nxt.B : cB;
        for (int t = 0; t < nt; t += 2) {
            const bool last = (t == nt - 2);
            const char* a1 = Abase + (size_t)(t + 1) * kstep;
            const char* a2 = Abase + (last ? (size_t)0 : (size_t)(t + 2) * kstep); const char* b2 = last ? nB : cB + (size_t)(t + 2) * kstep;
            const char* a3 = a2 + kstep; const char* b3 = b2 + kstep;
            unsigned o2[2][2];
#pragma unroll
            for (int h = 0; h < 2; ++h)
#pragma unroll
                for (int i = 0; i < 2; ++i) o2[h][i] = last ? nxtA[h][i] : curA[h][i];
            PG8_LDB(B0, 0, 0); PG8_LDB(B1, 0, 1); PG8_SCHED; PG8_LDA(At, 0, 0); PG8_STAGE(PG8_SA(1, 1), a1, curA[1]);
            PG8_WAIT_V(8); PG8_WAIT_L(0); PG8_BAR; PG8_MMA(0, 0, At, B0); PG8_MMA(0, 1, At, B1); PG8_BAR; PG8_SCHED;
            PG8_LDA(At, 0, 1); PG8_STAGE(PG8_SB(0, 0), b2, voffB); PG8_STAGE(PG8_SB(0, 1), b2 + hstep, voffB); PG8_STAGE(PG8_SA(0, 0), a2, o2[0]);
            PG8_WAIT_V(8); PG8_WAIT_L(0); PG8_BAR; PG8_MMA(1, 0, At, B0); PG8_MMA(1, 1, At, B1); PG8_BAR; PG8_SCHED;
            PG8_LDB(B0, 1, 0); PG8_LDB(B1, 1, 1); PG8_SCHED; PG8_LDA(At, 1, 0); PG8_STAGE(PG8_SA(0, 1), a2, o2[1]);
            PG8_WAIT_V(8); PG8_WAIT_L(0); PG8_BAR; PG8_MMA(0, 0, At, B0); PG8_MMA(0, 1, At, B1); PG8_BAR; PG8_SCHED;
            PG8_LDA(At, 1, 1); PG8_STAGE(PG8_SB(1, 0), b3, voffB); PG8_STAGE(PG8_SB(1, 1), b3 + hstep, voffB); PG8_STAGE(PG8_SA(1, 0), a3, o2[0]);
            PG8_WAIT_V(8); PG8_WAIT_L(0); PG8_BAR; PG8_MMA(1, 0, At, B0); PG8_MMA(1, 1, At, B1); PG8_BAR; PG8_SCHED;
        }
        if constexpr (ALIGN_EPI) { if (wr == 0) PG8_BAR; }
        E(acc, cur, wr, wc, fr, fq);
        if (!has_next) break;
#pragma unroll
        for (int a = 0; a < 2; ++a)
#pragma unroll
            for (int b = 0; b < 2; ++b)
#pragma unroll
                for (int m = 0; m < 4; ++m)
#pragma unroll
                    for (int n = 0; n < 2; ++n) acc[a][b][m][n] = (f32x4){0.f, 0.f, 0.f, 0.f};
        cur = nxt; cB = nB; ++ui;
#pragma unroll
        for (int h = 0; h < 2; ++h)
#pragma unroll
            for (int i = 0; i < 2; ++i) curA[h][i] = nxtA[h][i];
        if constexpr (ALIGN_EPI) { if (wr == 1) PG8_BAR; }
    }
    PG8_WAIT_V(0);
    if constexpr (!ALIGN_EPI) { if (wr == 0) PG8_BAR; }
    PG8_BAR;
#undef PG8_SA
#undef PG8_SB
#undef PG8_STAGE
#undef PG8_LDA
#undef PG8_LDB
#undef PG8_MMA
#undef PG8_WAIT_V
#undef PG8_WAIT_L
#undef PG8_BAR
#undef PG8_SCHED
}
#endif
}

#define XB_TMO      128
#define XB_XCNT(j)  (256  + 64 * (j))
#define XB_XSUB(j)  (1280 + 64 * (j))
#define XB_XGEN(j)  (2304 + 64 * (j))
#define XB_TOP      3328
#define XB_TOPGEN   3392
#define XCD_BAR_WORDS 3456
#define XB_SPIN_CAP (1u << 18)
__device__ __forceinline__ unsigned xb_ld(unsigned* p)              { return __hip_atomic_load(p, __ATOMIC_RELAXED, __HIP_MEMORY_SCOPE_AGENT); }
__device__ __forceinline__ unsigned xb_add(unsigned* p, unsigned v) { return __hip_atomic_fetch_add(p, v, __ATOMIC_RELAXED, __HIP_MEMORY_SCOPE_AGENT); }
__device__ __forceinline__ unsigned xb_xcc_id() { return (unsigned)__builtin_amdgcn_s_getreg((3 << 11) | 20) & 0xFu; }
#define XB_SPIN(cond, bar) do { unsigned _sp = 0; while (cond) { __builtin_amdgcn_s_sleep(1); \
    if ((++_sp & 255u) == 0u) { if (xb_ld(&(bar)[XB_TMO])) break; if (_sp > XB_SPIN_CAP) { atomicAdd(&(bar)[XB_TMO], 1u); break; } } } } while (0)
struct XcdBarrier { unsigned* bar; unsigned x; volatile LAS unsigned* st; };
__device__ __forceinline__ XcdBarrier xcd_barrier_post(unsigned* bar, volatile LAS unsigned* st) {
    XcdBarrier b; b.bar = bar; b.x = xb_xcc_id(); b.st = st;
    if (threadIdx.x == 0) (void)xb_add(&bar[XB_XCNT(b.x)], 1u);
    return b;
}
__device__ __forceinline__ void xcd_barrier_complete(unsigned* bar, unsigned x, unsigned& nloc, unsigned& nx) {
    const unsigned G = gridDim.x * gridDim.y * gridDim.z;
    unsigned sum, cnt, mine, sp = 0u;
    for (;;) {
        sum = 0u; cnt = 0u; mine = 0u;
#pragma unroll
        for (unsigned j = 0; j < 16; ++j) { const unsigned c = xb_ld(&bar[XB_XCNT(j)]); sum += c; cnt += (c > 0u) ? 1u : 0u; mine = (j == x) ? c : mine; }
        if (sum == G) break;
        __builtin_amdgcn_s_sleep(1);
        if ((++sp & 255u) == 0u) { if (xb_ld(&bar[XB_TMO])) break; if (sp > XB_SPIN_CAP) { atomicAdd(&bar[XB_TMO], 1u); break; } }
    }
    nloc = mine > 0u ? mine : 1u; nx = cnt > 0u ? cnt : 1u;
}
__device__ __forceinline__ void xcd_barrier(const XcdBarrier& b) {
    asm volatile("s_waitcnt vmcnt(0)" ::: "memory");
    __syncthreads();
    if (threadIdx.x == 0) {
        unsigned* bar = b.bar;
        __builtin_amdgcn_s_waitcnt(0);
        unsigned nloc = b.st[0], nx = b.st[1];
        if (nloc == 0u) { xcd_barrier_complete(bar, b.x, nloc, nx); b.st[0] = nloc; b.st[1] = nx; }
        const unsigned old = xb_add(&bar[XB_XSUB(b.x)], 1u);
        const unsigned gen = old / nloc;
        if (old + 1u == (gen + 1u) * nloc) {
            __builtin_amdgcn_fence(__ATOMIC_RELEASE, "agent");
            asm volatile("s_waitcnt vmcnt(0)" ::: "memory");
            const unsigned og = xb_add(&bar[XB_TOP], 1u);
            const unsigned tg = og / nx;
            if (og + 1u == (tg + 1u) * nx) xb_add(&bar[XB_TOPGEN], 1u);
            else XB_SPIN(xb_ld(&bar[XB_TOPGEN]) == tg, bar);
            __builtin_amdgcn_fence(__ATOMIC_ACQUIRE, "agent");
            xb_add(&bar[XB_XGEN(b.x)], 1u);
            asm volatile("s_waitcnt vmcnt(0)" ::: "memory");
        } else {
            XB_SPIN(xb_ld(&bar[XB_XGEN(b.x)]) == gen, bar);
            __builtin_amdgcn_fence(__ATOMIC_ACQUIRE, "agent");
            asm volatile("s_waitcnt vmcnt(0)" ::: "memory");
        }
    }
    __syncthreads();
}

struct Frame {
    LAS unsigned char* lds;
    volatile LAS unsigned* MISC;
    unsigned* ctl;
    int tid, lane, wave, vcu, G;
    const float* in[25]; float* out; unsigned char* ws;
};
enum { I_X = 0, I_WIN, I_CONVW, I_CONVB, I_WRG, I_BRG, I_WIG, I_BIG, I_LAM, I_SINKS, I_GATTN, I_GLRU, I_WOUT, I_LN1G, I_LN1B, I_WROUTER, I_EBIAS, I_WGATE, I_WUP, I_WDOWN, I_WSGATE, I_WSUP, I_WSDOWN, I_LN2G, I_LN2B };

__device__ __forceinline__ float wave_sum(float v) {
#pragma unroll
    for (int o = 1; o < 64; o <<= 1) v += __shfl_xor(v, o);
    return v;
}
#define LDS_WAIT() asm volatile("s_waitcnt lgkmcnt(0)" ::: "memory")

template <class RowMap>
__device__ __forceinline__ void p0_transpose_item(const float* W, int K, int ldw, bf16* WT, const RowMap& rm, LAS float* scr, int item, int lane) {
    const int nblk = ldw / 32, kb = item / nblk, nb = item % nblk, k0 = 64 * kb, n0 = 32 * nb;
#pragma unroll 8
    for (int i = 0; i < 32; ++i) { const int kk = 2 * i + (lane >> 5); scr[kk * 33 + (lane & 31)] = W[(size_t)(k0 + kk) * ldw + n0 + (lane & 31)]; }
    LDS_WAIT(); asm volatile("" ::: "memory");
    const int c = lane & 7;
#pragma unroll
    for (int j = 0; j < 4; ++j) { const int n = (lane >> 3) + 8 * j; const LAS float* s = scr + (8 * c) * 33 + n;
        v4u o; o.x = pk2(s[0 * 33], s[1 * 33]); o.y = pk2(s[2 * 33], s[3 * 33]); o.z = pk2(s[4 * 33], s[5 * 33]); o.w = pk2(s[6 * 33], s[7 * 33]);
        *(v4u*)(WT + (size_t)rm(n0 + n) * K + k0 + 8 * c) = o; }
    LDS_WAIT(); asm volatile("" ::: "memory");
}
struct MapIn {
    __device__ __forceinline__ int operator()(int n) const {
        if (n >= AW + KVW) return n;
        const int d = n & 63, p = 32 * ((d >> 4) & 1) + 8 * ((d >> 2) & 3) + 4 * (d >> 5) + (d & 3);
        return (n & ~63) + p;
    }
};
struct MapId { int off; __device__ __forceinline__ int operator()(int n) const { return off + n; } };
struct MapDown { __device__ __forceinline__ int operator()(int n) const {
        const int lg = n & 255, wc = lg >> 6, fq = (lg >> 4) & 3, bj = (lg >> 3) & 1, nn = (lg >> 2) & 1, j = lg & 3;
        return (n & ~255) + 128 * bj + 32 * wc + 8 * fq + 4 * nn + j; } };
struct MapGU { int up; __device__ __forceinline__ int operator()(int n) const { return (n >> 7) * 256 + up * 128 + (n & 127); } };

__device__ __forceinline__ void p0_prologue(Frame& F) {
    LAS float* scr = (LAS float*)(F.lds + F.wave * 16384);
    const int gw = F.vcu * NWAVES + F.wave, NGW = F.G * NWAVES;
    { bf16* Xb = (bf16*)(F.ws + WS_A1); const float* x = F.in[I_X];
      for (int m = gw; m < S; m += NGW) { const f32x4* xr = (const f32x4*)(x + (size_t)m * D) + F.lane; v2u* o = (v2u*)(Xb + (size_t)m * D) + F.lane;
#pragma unroll
          for (int j = 0; j < 4; ++j) { const f32x4 v = xr[64 * j]; v2u w; w.x = pk2(v.x, v.y); w.y = pk2(v.z, v.w); o[64 * j] = w; } } }
    {
        constexpr int I_IN = (D / 64) * (NIN / 32), I_OUT = (D / 64) * (D / 32), I_G = (D / 64) * (DE / 32), I_DN = (DE / 64) * (D / 32);
        constexpr int PER_E = 2 * I_G + I_DN;
        constexpr int NITEMS = I_IN + I_OUT + NEX * PER_E;
        bf16* WinT = (bf16*)(F.ws + WS_WIN); bf16* WoutT = (bf16*)(F.ws + WS_WOUT); bf16* WguT = (bf16*)(F.ws + WS_WGU); bf16* WdT = (bf16*)(F.ws + WS_WD);
        for (int it = gw; it < NITEMS; it += NGW) {
            int r = it;
            if (r < I_IN) { p0_transpose_item(F.in[I_WIN], D, NIN, WinT, MapIn{}, scr, r, F.lane); continue; } r -= I_IN;
            if (r < I_OUT) { p0_transpose_item(F.in[I_WOUT], D, D, WoutT, MapId{0}, scr, r, F.lane); continue; } r -= I_OUT;
            const int e = r / PER_E; r -= e * PER_E;
            const float* wg = e < NE ? F.in[I_WGATE] + (size_t)e * D * DE : F.in[I_WSGATE];
            const float* wu = e < NE ? F.in[I_WUP] + (size_t)e * D * DE : F.in[I_WSUP];
            const float* wd = e < NE ? F.in[I_WDOWN] + (size_t)e * DE * D : F.in[I_WSDOWN];
            if (r < I_G) { p0_transpose_item(wg, D, DE, WguT + (size_t)e * 512 * D, MapGU{0}, scr, r, F.lane); continue; } r -= I_G;
            if (r < I_G) { p0_transpose_item(wu, D, DE, WguT + (size_t)e * 512 * D, MapGU{1}, scr, r, F.lane); continue; } r -= I_G;
            p0_transpose_item(wd, DE, D, WdT + (size_t)e * D * DE, MapDown{}, scr, r, F.lane);
        }
    }
    {
        const int gt = F.vcu * 512 + F.tid, NGT = F.G * 512;
        float* rc = (float*)(F.ws + WS_ROPEC); float* rs = (float*)(F.ws + WS_ROPES);
        for (int i = gt; i < S * 32; i += NGT) { const int t = i >> 5, f = i & 31;
            const double inv = exp(-(double)f * (9.210340371976184 / 32.0)); const double ang = (double)t * inv;
            rc[i] = (float)cos(ang); rs[i] = (float)sin(ang); }
        int* tok = (int*)(F.ws + WS_TOK);
        for (int i = gt; i < NEX * LCAP; i += NGT) { const bool sh = i >= NE * LCAP; tok[i] = sh ? (i - NE * LCAP) : 0; }
        if (gt == 0) F.ctl[CW_CNT + 16 * NE] = (unsigned)S;
    }
}

struct DenseOrder {
    int nM, nN, nwg, G, c, K2; const char* Bt;
    __device__ void init(int M, int N, int K, const void* Bt_, int G_, int c_) { nM = M / 256; nN = N / 256; nwg = nM * nN; G = G_; c = c_; K2 = K * 2; Bt = (const char*)Bt_; }
    __device__ __forceinline__ bool next(int i, pg8::Unit& u) const {
        const long L = (long)i * G + c; if (L >= nwg) return false;
        int wgid = (int)L; { const int q = nwg / 8, r = nwg % 8, xcd = wgid % 8, off = wgid / 8; wgid = (xcd < r ? xcd * (q + 1) : r * (q + 1) + (xcd - r) * q) + off; }
        const int nig = 8 * nN, gid = wgid / nig, fm = gid * 8, gsz = (nM - fm) < 8 ? (nM - fm) : 8;
        const int pm = fm + ((wgid % nig) % gsz), pn = (wgid % nig) / gsz;
        u.B = Bt + (size_t)pn * 256 * K2; u.row0 = pm * 256; u.slot0 = 0; u.pn = pn; u.e = 0; u.cnt = 256; u.y0 = 0; return true;
    }
    __device__ __forceinline__ unsigned aoff(const pg8::Unit& u, int r) const { return (unsigned)(u.row0 + r) * (unsigned)K2; }
};
struct MoeOrder {
    const LAS int* tb; const LAS int* cl; const LAS int* rb; const int* tok; const char* Bt; size_t bstride_e, bstride_pn; int npn, G, c, total, K2; bool gather;
    __device__ __forceinline__ bool next(int i, pg8::Unit& u) const {
        const int L = i * G + c; if (L >= total) return false;
        const int pn = L % npn, T = L / npn;
        int e = 0;
        for (int s = 32; s >= 1; s >>= 1) { const int e2 = e + s; if (e2 <= NE && __builtin_amdgcn_readfirstlane(tb[e2]) <= T) e = e2; }
        if (e + 1 <= NE && __builtin_amdgcn_readfirstlane(tb[e + 1]) <= T) e = e + 1;
        const int j = T - __builtin_amdgcn_readfirstlane(tb[e]);
        u.e = e; u.pn = pn; u.row0 = T * 256; u.slot0 = e * LCAP + j * 256; u.cnt = __builtin_amdgcn_readfirstlane(cl[e]) - j * 256; u.y0 = __builtin_amdgcn_readfirstlane(rb[e]) + j * 256;
        u.B = Bt + (size_t)e * bstride_e + (size_t)pn * bstride_pn; return true;
    }
    __device__ __forceinline__ unsigned aoff(const pg8::Unit& u, int r) const {
        if (gather) return (unsigned)tok[u.slot0 + r] * (unsigned)K2;
        return (unsigned)(u.row0 + r) * (unsigned)K2;
    }
};

struct EpiInProj {
    static constexpr bool PERM = true;
    bf16 *Q, *Kb, *V, *XR, *YG; const float *rc, *rs;
    __device__ __forceinline__ void operator()(const f32x4 (&acc)[2][2][4][2], const pg8::Unit& u, int wr, int wc, int fr, int fq) const {
        const int pn = u.pn;
#pragma unroll
        for (int ai = 0; ai < 2; ++ai)
#pragma unroll
            for (int m = 0; m < 4; ++m) {
                const size_t row = (size_t)(u.row0 + ai * 128 + wr * 64 + m * 16 + fr);
#pragma unroll
                for (int bj = 0; bj < 2; ++bj) {
                    const f32x4 v0 = acc[ai][bj][m][0], v1 = acc[ai][bj][m][1];
                    if (pn < 2 || (pn == 2 && bj == 0)) {
                        const int d0 = 16 * (wc & 1) + 4 * fq;
                        const f32x4 c = *(const f32x4*)(rc + row * 32 + d0), s = *(const f32x4*)(rs + row * 32 + d0);
                        f32x4 o1 = v0 * c - v1 * s, o2 = v1 * c + v0 * s;
                        bf16* dst;
                        if (pn < 2) { o1 = o1 * 0.125f; o2 = o2 * 0.125f; dst = Q + row * AW + pn * 256 + bj * 128 + (wc >> 1) * 64; }
                        else dst = Kb + row * KVW + (wc >> 1) * 64;
                        v2u w1, w2; w1.x = pg8::cvt_pk_bf16(o1[0], o1[1]); w1.y = pg8::cvt_pk_bf16(o1[2], o1[3]); w2.x = pg8::cvt_pk_bf16(o2[0], o2[1]); w2.y = pg8::cvt_pk_bf16(o2[2], o2[3]);
                        *(v2u*)(dst + d0) = w1; *(v2u*)(dst + 32 + d0) = w2;
                    } else {
                        bf16* dst;
                        if (pn == 2) dst = V + row * KVW + wc * 32 + 8 * fq;
                        else if (pn < 5) dst = XR + row * LW + (pn - 3) * 256 + bj * 128 + wc * 32 + 8 * fq;
                        else dst = YG + row * LW + (pn - 5) * 256 + bj * 128 + wc * 32 + 8 * fq;
                        v4u w; w.x = pg8::cvt_pk_bf16(v0[0], v0[1]); w.y = pg8::cvt_pk_bf16(v0[2], v0[3]); w.z = pg8::cvt_pk_bf16(v1[0], v1[1]); w.w = pg8::cvt_pk_bf16(v1[2], v1[3]);
                        *(v4u*)dst = w;
                    }
                }
            }
    }
};
struct EpiZ {
    static constexpr bool PERM = false;
    float* Z; const float* x;
    __device__ __forceinline__ void operator()(const f32x4 (&acc)[2][2][4][2], const pg8::Unit& u, int wr, int wc, int fr, int fq) const {
#pragma unroll
        for (int ai = 0; ai < 2; ++ai)
#pragma unroll
            for (int m = 0; m < 4; ++m) {
                const size_t off = (size_t)(u.row0 + ai * 128 + wr * 64 + m * 16 + fr) * D + u.pn * 256 + wc * 32 + 4 * fq;
#pragma unroll
                for (int bj = 0; bj < 2; ++bj)
#pragma unroll
                    for (int n = 0; n < 2; ++n) { const f32x4 xv = *(const f32x4*)(x + off + bj * 128 + n * 16); *(f32x4*)(Z + off + bj * 128 + n * 16) = acc[ai][bj][m][n] + xv * ALPHA; }
            }
    }
};
__device__ __forceinline__ float silu_mul(float g, float u) { return g * u * __builtin_amdgcn_rcpf(1.0f + fast_exp(-g)); }
struct EpiAct {
    static constexpr bool PERM = true;
    bf16* ACT;
    __device__ __forceinline__ void operator()(const f32x4 (&acc)[2][2][4][2], const pg8::Unit& u, int wr, int wc, int fr, int fq) const {
#pragma unroll
        for (int ai = 0; ai < 2; ++ai)
#pragma unroll
            for (int m = 0; m < 4; ++m) {
                const size_t row = (size_t)(u.row0 + ai * 128 + wr * 64 + m * 16 + fr);
                const f32x4 g0 = acc[ai][0][m][0], g1 = acc[ai][0][m][1], u0 = acc[ai][1][m][0], u1 = acc[ai][1][m][1];
                v4u w;
                w.x = pg8::cvt_pk_bf16(silu_mul(g0[0], u0[0]), silu_mul(g0[1], u0[1])); w.y = pg8::cvt_pk_bf16(silu_mul(g0[2], u0[2]), silu_mul(g0[3], u0[3]));
                w.z = pg8::cvt_pk_bf16(silu_mul(g1[0], u1[0]), silu_mul(g1[1], u1[1])); w.w = pg8::cvt_pk_bf16(silu_mul(g1[2], u1[2]), silu_mul(g1[3], u1[3]));
                *(v4u*)(ACT + row * DE + u.pn * 128 + wc * 32 + 8 * fq) = w;
            }
    }
};
struct EpiY8 {
    static constexpr bool PERM = true;
    unsigned char* Y; float* out;
    __device__ __forceinline__ void operator()(const f32x4 (&acc)[2][2][4][2], const pg8::Unit& u, int wr, int wc, int fr, int fq) const {
        const int colb = u.pn * 256 + 64 * wc + 16 * fq;
        if (u.e == NE) {
#pragma unroll
            for (int ai = 0; ai < 2; ++ai)
#pragma unroll
                for (int m = 0; m < 4; ++m) {
                    const int r = ai * 128 + wr * 64 + m * 16 + fr;
                    float* o = out + (size_t)((u.slot0 - NE * LCAP) + r) * D + colb;
#pragma unroll
                    for (int bj = 0; bj < 2; ++bj)
#pragma unroll
                        for (int n = 0; n < 2; ++n) { f32x4 v = *(f32x4*)(o + 8 * bj + 4 * n); v = v + acc[ai][bj][m][n]; *(f32x4*)(o + 8 * bj + 4 * n) = v; }
                    asm volatile("" ::: "memory");
                }
        } else {
#pragma unroll
            for (int ai = 0; ai < 2; ++ai)
#pragma unroll
                for (int m = 0; m < 4; ++m) {
                    const int r = ai * 128 + wr * 64 + m * 16 + fr;
                    if (r < u.cnt) {
                        v4u w;
#pragma unroll
                        for (int bj = 0; bj < 2; ++bj)
#pragma unroll
                            for (int n = 0; n < 2; ++n) { const f32x4 v = acc[ai][bj][m][n] * 64.0f; int p = 0;
                                p = __builtin_amdgcn_cvt_pk_fp8_f32(v[0], v[1], p, false); p = __builtin_amdgcn_cvt_pk_fp8_f32(v[2], v[3], p, true); w[2 * bj + n] = (unsigned)p; }
                        *(v4u*)(Y + (size_t)(u.y0 + r) * D + colb) = w;
                    }
                }
        }
    }
};

__device__ __forceinline__ void attn_unit(Frame& F, int t0) {
    LAS bf16* Kl = (LAS bf16*)F.lds; LAS bf16* Vl = (LAS bf16*)(F.lds + 49152); LAS float* red = (LAS float*)(F.lds + 98304);
    const bf16* Qb = (const bf16*)(F.ws + WS_A2 + U_Q); const bf16* Kb = (const bf16*)(F.ws + WS_A2 + U_K); const bf16* Vb = (const bf16*)(F.ws + WS_A2 + U_V);
    bf16* MIX = (bf16*)(F.ws + WS_A1);
    for (int p = F.tid; p < 2 * 3072; p += 512) {
        const int which = p / 3072, q = p % 3072, kv = q / 1536, r = (q % 1536) / 8, ch = q % 8, kj = t0 - 128 + r;
        v4u val = (v4u){0u, 0u, 0u, 0u};
        if (kj >= 0) val = *(const v4u*)((which ? Vb : Kb) + (size_t)kj * KVW + kv * 64 + ch * 8);
        *(LAS v4u*)((which ? Vl : Kl) + (kv * 192 + r) * 64 + ch * 8) = val;
    }
    __syncthreads();
    const int h = F.wave, kv = h >> 2, t = t0 + F.lane;
    float q[64], o[64];
    { const v4u* qp = (const v4u*)(Qb + (size_t)t * AW + h * 64);
#pragma unroll
      for (int c = 0; c < 8; ++c) { const v4u v = qp[c];
#pragma unroll
          for (int k = 0; k < 4; ++k) { q[c * 8 + 2 * k] = bf2f(v[k] & 0xffffu); q[c * 8 + 2 * k + 1] = bf2f(v[k] >> 16); } } }
#pragma unroll
    for (int d = 0; d < 64; ++d) o[d] = 0.f;
    float mrun = F.in[I_SINKS][h], l = 1.0f;
    for (int j = 1; j < 192; ++j) {
        const bool valid = (j >= F.lane + 1) && (j <= F.lane + 128) && (t0 - 128 + j >= 0);
        const LAS v4u* kp = (const LAS v4u*)(Kl + (kv * 192 + j) * 64);
        float s = 0.f;
#pragma unroll
        for (int c = 0; c < 8; ++c) { const v4u v = kp[c];
#pragma unroll
            for (int k = 0; k < 4; ++k) { s += q[c * 8 + 2 * k] * bf2f(v[k] & 0xffffu); s += q[c * 8 + 2 * k + 1] * bf2f(v[k] >> 16); } }
        float al = 1.f, pw = 0.f;
        if (valid) { const float mn = fmaxf(mrun, s); al = fast_exp(mrun - mn); pw = fast_exp(s - mn); mrun = mn; }
        l = l * al + pw;
        const LAS v4u* vp = (const LAS v4u*)(Vl + (kv * 192 + j) * 64);
#pragma unroll
        for (int c = 0; c < 8; ++c) { const v4u v = vp[c];
#pragma unroll
            for (int k = 0; k < 4; ++k) { o[c * 8 + 2 * k] = o[c * 8 + 2 * k] * al + pw * bf2f(v[k] & 0xffffu); o[c * 8 + 2 * k + 1] = o[c * 8 + 2 * k + 1] * al + pw * bf2f(v[k] >> 16); } }
    }
    const float inv = 1.0f / l; float ssq = 0.f;
#pragma unroll
    for (int d = 0; d < 64; ++d) { o[d] *= inv; ssq += o[d] * o[d]; }
    red[h * 64 + F.lane] = ssq;
    __syncthreads();
    float tot = 0.f;
#pragma unroll
    for (int hh = 0; hh < 8; ++hh) tot += red[hh * 64 + F.lane];
    const float rsn = 1.0f / sqrtf(tot * (1.0f / AW) + NORM_EPS);
    const float* ga = F.in[I_GATTN] + h * 64;
    v4u* dst = (v4u*)(MIX + (size_t)t * D + h * 64);
#pragma unroll
    for (int c = 0; c < 8; ++c) { v4u w;
#pragma unroll
        for (int k = 0; k < 4; ++k) w[k] = pk2(o[c * 8 + 2 * k] * rsn * ga[c * 8 + 2 * k], o[c * 8 + 2 * k + 1] * rsn * ga[c * 8 + 2 * k + 1]);
        dst[c] = w; }
    __syncthreads();
}
__device__ __forceinline__ void lru_local_unit(Frame& F, int chunk) {
    LAS float* xcl = (LAS float*)F.lds;
    const int t0 = chunk * 64, c = F.tid, n = c >> 6, j = c & 63;
    const bf16* XR = (const bf16*)(F.ws + WS_A2 + U_XR);
    float* HL = F.out; float* PL = F.out + (size_t)S * LW;
    const float* cw = F.in[I_CONVW]; const float w0 = cw[c], w1 = cw[LW + c], w2 = cw[2 * LW + c], w3 = cw[3 * LW + c], cb = F.in[I_CONVB][c];
    float x0 = t0 >= 3 ? bf2f(XR[(size_t)(t0 - 3) * LW + c]) : 0.f, x1 = t0 >= 2 ? bf2f(XR[(size_t)(t0 - 2) * LW + c]) : 0.f, x2 = t0 >= 1 ? bf2f(XR[(size_t)(t0 - 1) * LW + c]) : 0.f;
#pragma unroll 4
    for (int tl = 0; tl < 64; ++tl) { const float x3 = bf2f(XR[(size_t)(t0 + tl) * LW + c]);
        xcl[tl * 512 + c] = cb + w0 * x0 + w1 * x1 + w2 * x2 + w3 * x3; x0 = x1; x1 = x2; x2 = x3; }
    __syncthreads();
    float wrg[64], wig[64];
    { const float* a = F.in[I_WRG] + (size_t)n * 4096 + j; const float* b = F.in[I_WIG] + (size_t)n * 4096 + j;
      asm volatile("" : "+v"(a), "+v"(b));
#pragma unroll
      for (int i = 0; i < 64; ++i) { wrg[i] = a[i * 64]; wig[i] = b[i * 64]; } }
    const float brg = F.in[I_BRG][c], big = F.in[I_BIG][c];
    const float lam = F.in[I_LAM][c]; const float sp = log1pf(expf(-lam));
    float hrun = 0.f, prun = 1.f;
#pragma unroll 1
    for (int tl = 0; tl < 64; ++tl) {
        float ar = brg, ai = big;
        const LAS f32x4* xp = (const LAS f32x4*)(xcl + tl * 512 + n * 64);
#pragma unroll
        for (int i4 = 0; i4 < 16; ++i4) { const f32x4 xv = xp[i4];
#pragma unroll
            for (int k = 0; k < 4; ++k) { ar += xv[k] * wrg[i4 * 4 + k]; ai += xv[k] * wig[i4 * 4 + k]; } }
        const float r = sigmoidf_(ar), ig = sigmoidf_(ai);
        const float log_a = -8.0f * r * sp; const float a = expf(log_a);
        const float mult = sqrtf(-expm1f(2.0f * log_a));
        const float inp = mult * (ig * xcl[tl * 512 + c]);
        hrun = a * hrun + inp; prun *= a;
        HL[(size_t)(t0 + tl) * LW + c] = hrun; PL[(size_t)(t0 + tl) * LW + c] = prun;
    }
    float* agg = (float*)(F.ws + WS_AGG);
    *(f32x2*)(agg + ((size_t)chunk * LW + c) * 2) = (f32x2){prun, hrun};
    __syncthreads();
}
__device__ __forceinline__ float gelu_tanh(float x) { const float u = 0.7978845608028654f * (x + 0.044715f * x * x * x); const float e = fast_exp(2.0f * u); return 0.5f * x * (1.0f + (1.0f - 2.0f / (e + 1.0f))); }
__device__ __forceinline__ void lru_fix_unit(Frame& F, int chunk) {
    LAS float* part = (LAS float*)F.lds;
    const int t0 = chunk * 64, c = F.tid;
    const float* agg = (const float*)(F.ws + WS_AGG);
    float carry = 0.f;
    for (int k = 0; k < chunk; ++k) { const f32x2 a = *(const f32x2*)(agg + ((size_t)k * LW + c) * 2); carry = a.x * carry + a.y; }
    const float* HL = F.out; const float* PL = F.out + (size_t)S * LW;
    const bf16* YG = (const bf16*)(F.ws + WS_A2 + U_YG);
    float y[64];
#pragma unroll
    for (int tl = 0; tl < 64; ++tl) { const size_t o = (size_t)(t0 + tl) * LW + c; const float hv = HL[o] + PL[o] * carry; y[tl] = gelu_tanh(bf2f(YG[o])) * hv; }
#pragma unroll
    for (int tl = 0; tl < 64; ++tl) { const float s = wave_sum(y[tl] * y[tl]); if (F.lane == 0) part[tl * 8 + F.wave] = s; }
    __syncthreads();
    const float g = F.in[I_GLRU][c];
    bf16* MIX = (bf16*)(F.ws + WS_A1);
#pragma unroll
    for (int tl = 0; tl < 64; ++tl) { float tot = 0.f;
#pragma unroll
        for (int w = 0; w < 8; ++w) tot += part[tl * 8 + w];
        const float rsn = 1.0f / sqrtf(tot * (1.0f / LW) + NORM_EPS);
        MIX[(size_t)(t0 + tl) * D + AW + c] = (bf16)f2bf(y[tl] * rsn * g); }
    __syncthreads();
}
__device__ __forceinline__ void route_unit(Frame& F, int unit) {
    LAS float* hrow = (LAS float*)F.lds;
    LAS float* lg = (LAS float*)(F.lds + SCR_OFF);
    LAS float* sc = lg + 32 * 65;
    const int t0 = unit * 32;
    const float* Z = (const float*)(F.ws + WS_A2);
    bf16* H1b = (bf16*)(F.ws + WS_A1);
    const float* g1 = F.in[I_LN1G]; const float* b1 = F.in[I_LN1B];
    for (int rr = 0; rr < 4; ++rr) {
        const int tl = F.wave * 4 + rr; const size_t row = (size_t)(t0 + tl);
        const f32x4* zr = (const f32x4*)(Z + row * D) + F.lane;
        f32x4 v[4]; float s = 0.f;
#pragma unroll
        for (int j = 0; j < 4; ++j) { v[j] = zr[64 * j]; s += (v[j].x + v[j].y) + (v[j].z + v[j].w); }
        const float mean = wave_sum(s) * (1.f / D); float s2 = 0.f;
#pragma unroll
        for (int j = 0; j < 4; ++j) { v[j] = v[j] - mean; s2 += (v[j].x * v[j].x + v[j].y * v[j].y) + (v[j].z * v[j].z + v[j].w * v[j].w); }
        const float rstd = 1.f / sqrtf(wave_sum(s2) * (1.f / D) + NORM_EPS);
#pragma unroll
        for (int j = 0; j < 4; ++j) {
            const f32x4 gg = *((const f32x4*)g1 + F.lane + 64 * j), bb = *((const f32x4*)b1 + F.lane + 64 * j);
            const f32x4 hv = v[j] * rstd * gg + bb;
            *((LAS f32x4*)(hrow + tl * 1024) + F.lane + 64 * j) = hv;
            *((f32x4*)(F.out + row * D) + F.lane + 64 * j) = hv * ALPHA;
            v2u w; w.x = pk2(hv.x, hv.y); w.y = pk2(hv.z, hv.w); *((v2u*)(H1b + row * D) + F.lane + 64 * j) = w;
        }
    }
    __syncthreads();
    {
        const float* wr_ = F.in[I_WROUTER] + F.lane;
        float a0 = 0.f, a1 = 0.f, a2 = 0.f, a3 = 0.f;
        const LAS f32x4* h0 = (const LAS f32x4*)(hrow + (F.wave * 4 + 0) * 1024); const LAS f32x4* h1 = (const LAS f32x4*)(hrow + (F.wave * 4 + 1) * 1024);
        const LAS f32x4* h2 = (const LAS f32x4*)(hrow + (F.wave * 4 + 2) * 1024); const LAS f32x4* h3 = (const LAS f32x4*)(hrow + (F.wave * 4 + 3) * 1024);
        for (int k4 = 0; k4 < 256; ++k4) {
            const f32x4 x0 = h0[k4], x1 = h1[k4], x2 = h2[k4], x3 = h3[k4];
#pragma unroll
            for (int k = 0; k < 4; ++k) { const float w = wr_[(size_t)(k4 * 4 + k) * NE]; a0 += x0[k] * w; a1 += x1[k] * w; a2 += x2[k] * w; a3 += x3[k] * w; }
        }
        const float eb = F.in[I_EBIAS][F.lane];
        const float s0 = sigmoidf_(a0), s1 = sigmoidf_(a1), s2 = sigmoidf_(a2), s3 = sigmoidf_(a3);
        const int tb = F.wave * 4;
        sc[(tb + 0) * 65 + F.lane] = s0; sc[(tb + 1) * 65 + F.lane] = s1; sc[(tb + 2) * 65 + F.lane] = s2; sc[(tb + 3) * 65 + F.lane] = s3;
        lg[(tb + 0) * 65 + F.lane] = s0 + eb; lg[(tb + 1) * 65 + F.lane] = s1 + eb; lg[(tb + 2) * 65 + F.lane] = s2 + eb; lg[(tb + 3) * 65 + F.lane] = s3 + eb;
    }
    __syncthreads();
    if (F.tid < 32) {
        const int tl = F.tid, t = t0 + tl;
        LAS float* L = lg + tl * 65; const LAS float* Sc = sc + tl * 65;
        float gs[8];
#pragma unroll
        for (int g = 0; g < 8; ++g) { float m1 = -INFINITY, m2 = -INFINITY;
            for (int i = 0; i < 8; ++i) { const float v = L[g * 8 + i]; if (v > m1) { m2 = m1; m1 = v; } else if (v > m2) m2 = v; }
            gs[g] = m1 + m2; }
        unsigned gsel = 0;
#pragma unroll
        for (int r = 0; r < 4; ++r) { int bg = 0; float bv = -INFINITY;
#pragma unroll
            for (int g = 0; g < 8; ++g) if (!((gsel >> g) & 1u) && gs[g] > bv) { bv = gs[g]; bg = g; }
            gsel |= 1u << bg; }
        int idx[8]; float w[8]; float wsum = 0.f;
#pragma unroll
        for (int k = 0; k < 8; ++k) { int be = 0; float bv = -INFINITY;
            for (int e = 0; e < NE; ++e) if ((gsel >> (e >> 3)) & 1u) { const float v = L[e]; if (v > bv) { bv = v; be = e; } }
            L[be] = -INFINITY; idx[k] = be; w[k] = Sc[be]; wsum += w[k]; }
        const float scale = 2.5f / wsum;
        int* tok = (int*)(F.ws + WS_TOK); int* rie = (int*)(F.ws + WS_RIE) + (size_t)t * 8; float* riw = (float*)(F.ws + WS_RIW) + (size_t)t * 8;
        unsigned slot[8];
#pragma unroll
        for (int k = 0; k < 8; ++k) slot[k] = atomicAdd(F.ctl + CW_CNT + 16 * idx[k], 1u);
#pragma unroll
        for (int k = 0; k < 8; ++k) { tok[idx[k] * LCAP + slot[k]] = t; rie[k] = idx[k] | (int)(slot[k] << 8); riw[k] = w[k] * scale; }
    }
    __syncthreads();
}
__device__ __forceinline__ void combine_rows(Frame& F, const LAS int* rb) {
    const int gw = F.vcu * NWAVES + F.wave, NGW = F.G * NWAVES;
    const float* g2 = F.in[I_LN2G]; const float* b2 = F.in[I_LN2B];
    const unsigned char* Y = F.ws + WS_Y8; const int* rie = (const int*)(F.ws + WS_RIE); const float* riw = (const float*)(F.ws + WS_RIW);
    for (int m = gw; m < S; m += NGW) {
        f32x4* xr = (f32x4*)(F.out + (size_t)m * D) + F.lane * 4;
        f32x4 v[4];
#pragma unroll
        for (int j = 0; j < 4; ++j) v[j] = xr[j];
        const int ek = rie[(size_t)m * 8 + (F.lane & 7)]; const float wk = riw[(size_t)m * 8 + (F.lane & 7)] * (1.0f / 64.0f);
#pragma unroll
        for (int k = 0; k < 8; ++k) {
            const int ee = __builtin_amdgcn_readlane(ek, k); const float ww = __int_as_float(__builtin_amdgcn_readlane(__float_as_int(wk), k));
            const int row = rb[ee & 255] + (ee >> 8);
            const v4u y = *(const v4u*)(Y + (size_t)row * D + F.lane * 16);
#pragma unroll
            for (int j = 0; j < 4; ++j) { const f32x2 a = __builtin_amdgcn_cvt_pk_f32_fp8((int)y[j], false), b = __builtin_amdgcn_cvt_pk_f32_fp8((int)y[j], true);
                v[j].x += ww * a.x; v[j].y += ww * a.y; v[j].z += ww * b.x; v[j].w += ww * b.y; }
        }
        float s = 0.f;
#pragma unroll
        for (int j = 0; j < 4; ++j) s += (v[j].x + v[j].y) + (v[j].z + v[j].w);
        const float mean = wave_sum(s) * (1.f / D); float s2 = 0.f;
#pragma unroll
        for (int j = 0; j < 4; ++j) { v[j] = v[j] - mean; s2 += (v[j].x * v[j].x + v[j].y * v[j].y) + (v[j].z * v[j].z + v[j].w * v[j].w); }
        const float rstd = 1.f / sqrtf(wave_sum(s2) * (1.f / D) + NORM_EPS);
#pragma unroll
        for (int j = 0; j < 4; ++j) { const f32x4 gg = *((const f32x4*)g2 + F.lane * 4 + j), bb = *((const f32x4*)b2 + F.lane * 4 + j); xr[j] = v[j] * rstd * gg + bb; }
    }
}
__device__ __forceinline__ void moe_table(Frame& F, LAS int* tb, LAS int* cl, LAS int* rb) {
    if (F.tid == 0) { int acc = 0, racc = 0; for (int e = 0; e < NEX; ++e) { const int c = (int)F.ctl[CW_CNT + 16 * e]; cl[e] = c; tb[e] = acc; rb[e] = racc; acc += (c + 255) >> 8; racc += c; } tb[NEX] = acc; rb[NEX] = racc; }
    __syncthreads();
}

struct Args { const float* in[25]; float* out; unsigned char* ws; int ph_lo, ph_hi, li, pad; };
__global__ void __launch_bounds__(NWAVES * 64, 2) fwd(Args args) {
    extern __shared__ __attribute__((aligned(16))) unsigned char lds[];
    Frame F;
    F.lds = (LAS unsigned char*)lds;
    F.MISC = (volatile LAS unsigned*)(F.lds + MISC_OFF);
    F.tid = threadIdx.x; F.lane = F.tid & 63; F.wave = __builtin_amdgcn_readfirstlane(F.tid >> 6);
    F.G = gridDim.x; { const int bx = blockIdx.x; F.vcu = (F.G % 8 == 0) ? (bx % 8) * (F.G / 8) + bx / 8 : bx; }
    F.ws = args.ws; F.out = args.out; F.ctl = (unsigned*)(args.ws + WS_CTL);
#pragma unroll
    for (int i = 0; i < 25; ++i) F.in[i] = args.in[i];
    for (int u = F.tid; u < 128; u += NWAVES * 64) ((LAS unsigned*)(F.lds + MISC_OFF))[u] = 0u;
    __syncthreads();
    XcdBarrier bar; bar.bar = F.ctl + CW_BAR; bar.x = 0; bar.st = nullptr;
    if (MK_N_LAUNCHES == 1) bar = xcd_barrier_post(F.ctl + CW_BAR, F.MISC + 8);
    const int lo = args.ph_lo, hi = args.ph_hi;
#ifndef PH_MASK
#define PH_MASK 0x1ff
#endif
#define IN(k) (((PH_MASK >> (k)) & 1) && lo <= (k) && (k) < hi)
#define BOTH(k) (IN(k) && IN((k) + 1))
#define GRID_BAR() do { if (MK_N_LAUNCHES == 1) xcd_barrier(bar); } while (0)

    if (IN(0)) { p0_prologue(F); if (BOTH(0)) GRID_BAR(); }
    if (IN(1)) {
        DenseOrder So; So.init(S, NIN, D, F.ws + WS_WIN, F.G, (int)blockIdx.x);
        EpiInProj E{(bf16*)(F.ws + WS_A2 + U_Q), (bf16*)(F.ws + WS_A2 + U_K), (bf16*)(F.ws + WS_A2 + U_V), (bf16*)(F.ws + WS_A2 + U_XR), (bf16*)(F.ws + WS_A2 + U_YG), (const float*)(F.ws + WS_ROPEC), (const float*)(F.ws + WS_ROPES)};
        pg8::gemm_phase<EpiInProj, DenseOrder, true>(F.lds, (const char*)(F.ws + WS_A1), D, So, E);
        if (BOTH(1)) GRID_BAR();
    }
    if (IN(2)) {
        for (int u = F.vcu; u < S / 64; u += F.G) { attn_unit(F, u * 64); lru_local_unit(F, u); }
        if (BOTH(2)) GRID_BAR();
    }
    if (IN(3)) {
        for (int u = F.vcu; u < S / 64; u += F.G) lru_fix_unit(F, u);
        if (BOTH(3)) GRID_BAR();
    }
    if (IN(4)) {
        DenseOrder So; So.init(S, D, D, F.ws + WS_WOUT, F.G, (int)blockIdx.x);
        EpiZ E{(float*)(F.ws + WS_A2), F.in[I_X]};
        pg8::gemm_phase<EpiZ, DenseOrder, true>(F.lds, (const char*)(F.ws + WS_A1), D, So, E);
        if (BOTH(4)) GRID_BAR();
    }
    if (IN(5)) {
        for (int u = F.vcu; u < S / 32; u += F.G) route_unit(F, u);
        if (BOTH(5)) GRID_BAR();
    }
    if (IN(6)) {
        LAS int* tb = (LAS int*)(F.lds + SCR_OFF); LAS int* cl = tb + 128; LAS int* rb = tb + 256;
        moe_table(F, tb, cl, rb);
        MoeOrder So{tb, cl, rb, (const int*)(F.ws + WS_TOK), (const char*)(F.ws + WS_WGU), (size_t)512 * D * 2, (size_t)256 * D * 2, 2, F.G, F.vcu, tb[NEX] * 2, D * 2, true};
        EpiAct E{(bf16*)(F.ws + WS_A2)};
        pg8::gemm_phase<EpiAct, MoeOrder, true>(F.lds, (const char*)(F.ws + WS_A1), D, So, E);
        if (BOTH(6)) GRID_BAR();
    }
    if (IN(7)) {
        LAS int* tb = (LAS int*)(F.lds + SCR_OFF); LAS int* cl = tb + 128; LAS int* rb = tb + 256;
        moe_table(F, tb, cl, rb);
        MoeOrder So{tb, cl, rb, (const int*)(F.ws + WS_TOK), (const char*)(F.ws + WS_WD), (size_t)D * DE * 2, (size_t)256 * DE * 2, 4, F.G, F.vcu, tb[NEX] * 4, DE * 2, false};
        EpiY8 E{F.ws + WS_Y8, F.out};
        pg8::gemm_phase<EpiY8, MoeOrder, true>(F.lds, (const char*)(F.ws + WS_A2), DE, So, E);
        if (BOTH(7)) GRID_BAR();
    }
    if (IN(8)) {
        LAS int* tb = (LAS int*)(F.lds + SCR_OFF); LAS int* cl = tb + 128; LAS int* rb = tb + 256;
        moe_table(F, tb, cl, rb);
        combine_rows(F, rb);
    }
#undef IN
#undef BOTH
#undef GRID_BAR
}

extern "C" void kernel_launch(void* const* d_in, const int* in_sizes, int n_in, void* d_out, int out_size, void* d_ws, size_t ws_size, hipStream_t stream) {
    static int grid = 0;
    if (grid == 0) {
        if (n_in != 25 || out_size != S * D || ws_size < WS_END) { fprintf(stderr, "kernel_launch: unexpected shapes (n_in %d out %d ws %zu)\n", n_in, out_size, ws_size); grid = -1; return; }
        int dev = 0, cus = 0, per_cu = 0;
        if (hipGetDevice(&dev) != hipSuccess || hipDeviceGetAttribute(&cus, hipDeviceAttributeMultiprocessorCount, dev) != hipSuccess) { grid = -1; return; }
        if (hipFuncSetAttribute((const void*)fwd, hipFuncAttributeMaxDynamicSharedMemorySize, LDS_BYTES) != hipSuccess) { fprintf(stderr, "kernel_launch: hipFuncSetAttribute failed\n"); grid = -1; return; }
        if (hipOccupancyMaxActiveBlocksPerMultiprocessor(&per_cu, (const void*)fwd, NWAVES * 64, LDS_BYTES) != hipSuccess || per_cu < 1) fprintf(stderr, "kernel_launch: occupancy query says %d\n", per_cu);
        (void)hipGetLastError();
        grid = cus;
    }
    if (grid < 0) return;
    if (hipMemsetAsync((char*)d_ws + WS_CTL, 0, CTL_ZERO_BYTES, stream) != hipSuccess) return;
    Args a{};
    for (int i = 0; i < 25; ++i) a.in[i] = (const float*)d_in[i];
    a.out = (float*)d_out; a.ws = (unsigned char*)d_ws;
    for (int li = 0; li < MK_N_LAUNCHES; ++li) {
        a.ph_lo = (MK_N_LAUNCHES == 1) ? 0 : li; a.ph_hi = (MK_N_LAUNCHES == 1) ? NPHASE : li + 1; a.li = li;
        hipLaunchKernelGGL(fwd, dim3(grid), dim3(NWAVES * 64), LDS_BYTES, stream, a);
    }
}
```

```cpp
#include <hip/hip_runtime.h>
#include <cstdio>
#include <cstdint>

#ifndef MK_N_LAUNCHES
#define MK_N_LAUNCHES 1
#endif
#ifndef GEMM_REF
#define GEMM_REF 0
#endif

#define LAS __attribute__((address_space(3)))
#define GAS __attribute__((address_space(1)))
typedef unsigned short bf16;
typedef unsigned v4u __attribute__((ext_vector_type(4)));
typedef unsigned v2u __attribute__((ext_vector_type(2)));
typedef float f32x4 __attribute__((ext_vector_type(4)));
typedef float f32x2 __attribute__((ext_vector_type(2)));
typedef short bf16x8 __attribute__((ext_vector_type(8)));

constexpr int S = 16384, D = 1024, NIN = 1792, AW = 512, KVW = 128, LW = 512, NE = 64, NEX = 65, DE = 256, TOPK = 8;
constexpr int LCAP = 16384;
constexpr float ALPHA = 1.18920711500272f;
constexpr float NORM_EPS = 1e-5f;
constexpr int NWAVES = 8;
constexpr int NPHASE = 9;

constexpr size_t MiB = 1u << 20;
constexpr size_t WS_CTL = 0, CTL_ZERO_BYTES = 1 * MiB;
constexpr size_t WS_ROPEC = 1 * MiB, WS_ROPES = 3 * MiB;
constexpr size_t WS_AGG = 5 * MiB;
constexpr size_t WS_RIE = 6 * MiB;
constexpr size_t WS_RIW = 6 * MiB + 512 * 1024;
constexpr size_t WS_TOK = 7 * MiB;
constexpr size_t WS_WIN = 17 * MiB;
constexpr size_t WS_WOUT = 21 * MiB;
constexpr size_t WS_WD = 23 * MiB;
constexpr size_t WS_A2 = 56 * MiB;
constexpr size_t WS_WGU = 136 * MiB;
constexpr size_t WS_A1 = 201 * MiB;
constexpr size_t WS_Y8 = 136 * MiB;
constexpr size_t WS_END = 264 * MiB;
constexpr size_t U_Q = 0, U_K = 16 * MiB, U_V = 20 * MiB, U_XR = 24 * MiB, U_YG = 40 * MiB;
constexpr int CW_BAR = 4096;
constexpr int CW_CNT = 16384;

constexpr int RING_BYTES = 131072;
constexpr int SCR_OFF = RING_BYTES, SCR_BYTES = 20480;
constexpr int MISC_OFF = SCR_OFF + SCR_BYTES;
constexpr int LDS_BYTES = MISC_OFF + 512;

__device__ __forceinline__ float bf2f(unsigned b) { return __uint_as_float(b << 16); }
__device__ __forceinline__ unsigned f2bf(float f) { unsigned u = __float_as_uint(f); return (u + 0x7fffu + ((u >> 16) & 1u)) >> 16; }
__device__ __forceinline__ unsigned pk2(float lo, float hi) { return f2bf(lo) | (f2bf(hi) << 16); }
__device__ __forceinline__ float fast_exp(float x) { return __builtin_amdgcn_exp2f(x * 1.44269504089f); }
__device__ __forceinline__ float sigmoidf_(float x) { return 1.0f / (1.0f + fast_exp(-x)); }

namespace pg8 {
constexpr int BM = 256, BK = 64, HALF = 128, HTB = HALF * BK * 2, STAGE_BYTES = 8 * HTB, NXCD = 8, WGM = 8;
__host__ __device__ __forceinline__ int lds_byte(int r, int c) { const int st = (r >> 4) * 2 + (c >> 5), rr = r & 15, cc = c & 31, ob = rr * 64 + cc * 2; return st * 1024 + (ob ^ (((ob >> 9) & 1) << 5)); }
__host__ __device__ __forceinline__ void stage_rc(int b, int& R, int& C) { const int st = b / 1024, sb = b % 1024, swz = sb ^ (((sb >> 9) & 1) << 5); R = (st >> 1) * 16 + swz / 64; C = (st & 1) * 32 + (swz % 64) / 2; }
__host__ __device__ __forceinline__ int perm32(int rho) { const int n = rho >> 4, i = rho & 15; return 8 * (i >> 2) + 4 * n + (i & 3); }

struct Unit { const char* B; int row0; int slot0; int pn; int e; int cnt; int y0; };

__device__ __forceinline__ unsigned cvt_pk_bf16(float lo, float hi) { unsigned r; asm volatile("v_cvt_pk_bf16_f32 %0, %1, %2" : "=v"(r) : "v"(lo), "v"(hi)); return r; }

#if GEMM_REF
template <class Epi, class Sched, bool ALIGN_EPI>
__device__ __forceinline__ void gemm_phase(LAS unsigned char* lds, const char* Abase, const int K, const Sched& S, const Epi& E) {
    const int tid = threadIdx.x, wid = __builtin_amdgcn_readfirstlane(tid >> 6), lane = tid & 63, wr = wid >> 2, wc = wid & 3, fr = lane & 15, fq = lane >> 4;
    Unit cur;
    for (int ui = 0; S.next(ui, cur); ++ui) {
        f32x4 acc[2][2][4][2];
#pragma unroll
        for (int ai = 0; ai < 2; ++ai)
#pragma unroll
            for (int bj = 0; bj < 2; ++bj)
#pragma unroll
                for (int m = 0; m < 4; ++m)
#pragma unroll
                    for (int n = 0; n < 2; ++n)
#pragma unroll
                        for (int j = 0; j < 4; ++j) {
                            const int row = ai * 128 + wr * 64 + m * 16 + fr;
                            const int col = bj * 128 + wc * 32 + (Epi::PERM ? (8 * fq + 4 * n + j) : (16 * n + 4 * fq + j));
                            const bf16* a = (const bf16*)(Abase + S.aoff(cur, row)); const bf16* b = (const bf16*)(cur.B) + (size_t)col * K;
                            float s = 0.f;
                            for (int k = 0; k < K; k += 8) { const v4u av = *(const v4u*)(a + k), bv = *(const v4u*)(b + k);
#pragma unroll
                                for (int q = 0; q < 4; ++q) { s += bf2f(av[q] & 0xffffu) * bf2f(bv[q] & 0xffffu); s += bf2f(av[q] >> 16) * bf2f(bv[q] >> 16); } }
                            acc[ai][bj][m][n][j] = s;
                        }
        E(acc, cur, wr, wc, fr, fq);
    }
    __syncthreads();
}
#else
template <class Epi, class Sched, bool ALIGN_EPI>
__device__ __forceinline__ void gemm_phase(LAS unsigned char* lds, const char* Abase, const int K_, const Sched& S, const Epi& E) {
    const int tid = threadIdx.x, wid = __builtin_amdgcn_readfirstlane(tid >> 6), lane = tid & 63, wr = wid >> 2, wc = wid & 3, fr = lane & 15, fq = lane >> 4;
    int K = K_; asm volatile("" : "+s"(K));
    const int nt = K / BK;
    int RA[2]; unsigned CA2[2], voffB[2];
#pragma unroll
    for (int i = 0; i < 2; ++i) { int R, C; stage_rc(tid * 16 + i * 8192, R, C); const int Rb = Epi::PERM ? ((R & ~31) + perm32(R & 31)) : R;
        RA[i] = R; CA2[i] = (unsigned)C * 2u; voffB[i] = (unsigned)(Rb * K + C) * 2u; }
    const size_t kstep = (size_t)(BK * 2);
    const size_t hstep = (size_t)HALF * K * 2;
    const unsigned ldsw = (unsigned)wid * 1024u;
    const int aoff = lds_byte(wr * 64 + fr, fq * 8), boff = lds_byte(wc * 32 + fr, fq * 8);
#define PG8_SA(b, h) (((b) * 2 + (h)) * HTB)
#define PG8_SB(b, h) ((4 + (b) * 2 + (h)) * HTB)
#define PG8_STAGE(bufoff, gbase, voff) do { _Pragma("unroll") for (int _i = 0; _i < 2; ++_i) \
        __builtin_amdgcn_global_load_lds((const unsigned*)((const char*)(gbase) + (voff)[_i]), (LAS unsigned*)(lds + (bufoff) + ldsw + _i * 8192), 16, 0, 0); } while (0)
#define PG8_LDA(dst, b, h) do { _Pragma("unroll") for (int m = 0; m < 4; ++m) _Pragma("unroll") for (int k = 0; k < 2; ++k) dst[m][k] = *(const LAS bf16x8*)(lds + PG8_SA(b, h) + aoff + m * 2048 + k * 1024); } while (0)
#define PG8_LDB(dst, b, h) do { _Pragma("unroll") for (int n = 0; n < 2; ++n) _Pragma("unroll") for (int k = 0; k < 2; ++k) dst[n][k] = *(const LAS bf16x8*)(lds + PG8_SB(b, h) + boff + n * 2048 + k * 1024); } while (0)
#define PG8_MMA(ai, bj, At, Bt) do { __builtin_amdgcn_s_setprio(1); _Pragma("unroll") for (int m = 0; m < 4; ++m) _Pragma("unroll") for (int n = 0; n < 2; ++n) _Pragma("unroll") for (int k = 0; k < 2; ++k) \
        acc[ai][bj][m][n] = __builtin_amdgcn_mfma_f32_16x16x32_bf16(Bt[n][k], At[m][k], acc[ai][bj][m][n], 0, 0, 0); __builtin_amdgcn_s_setprio(0); } while (0)
#define PG8_WAIT_V(n) asm volatile("s_waitcnt vmcnt(" #n ")" ::: "memory")
#define PG8_WAIT_L(n) asm volatile("s_waitcnt lgkmcnt(" #n ")" ::: "memory")
#define PG8_BAR __builtin_amdgcn_s_barrier()
#define PG8_SCHED __builtin_amdgcn_sched_barrier(0)
    Unit cur, nxt; int ui = 0;
    if (!S.next(0, cur)) return;
    unsigned curA[2][2], nxtA[2][2];
#pragma unroll
    for (int h = 0; h < 2; ++h)
#pragma unroll
        for (int i = 0; i < 2; ++i) curA[h][i] = S.aoff(cur, h * HALF + RA[i]) + CA2[i];
    f32x4 acc[2][2][4][2];
#pragma unroll
    for (int a = 0; a < 2; ++a)
#pragma unroll
        for (int b = 0; b < 2; ++b)
#pragma unroll
            for (int m = 0; m < 4; ++m)
#pragma unroll
                for (int n = 0; n < 2; ++n) acc[a][b][m][n] = (f32x4){0.f, 0.f, 0.f, 0.f};
    bf16x8 At[4][2], B0[2][2], B1[2][2];
    const char* cB = cur.B;
    PG8_STAGE(PG8_SB(0, 0), cB, voffB); PG8_STAGE(PG8_SB(0, 1), cB + hstep, voffB); PG8_STAGE(PG8_SA(0, 0), Abase, curA[0]); PG8_STAGE(PG8_SA(0, 1), Abase, curA[1]);
    if (wr == 1) PG8_BAR;
    PG8_WAIT_V(2); PG8_BAR;
    PG8_STAGE(PG8_SB(1, 0), cB + kstep, voffB); PG8_STAGE(PG8_SA(1, 0), Abase + kstep, curA[0]); PG8_STAGE(PG8_SB(1, 1), cB + hstep + kstep, voffB);
    PG8_WAIT_V(6); PG8_BAR;
    for (;;) {
        const bool has_next = S.next(ui + 1, nxt);
#pragma unroll
        for (int h = 0; h < 2; ++h)
#pragma unroll
            for (int i = 0; i < 2; ++i) nxtA[h][i] = has_next ? (S.aoff(nxt, h * HALF + RA[i]) + CA2[i]) : curA[h][i];
        const char* nB = has_next ? nxt.B : cB;
        for (int t = 0; t < nt; t += 2) {
            const bool last = (t == nt - 2);
            const char* a1 = Abase + (size_t)(t + 1) * kstep;
            const char* a2 = Abase + (last ? (size_t)0 : (size_t)(t + 2) * kstep); const char* b2 = last ? nB : cB + (size_t)(t + 2) * kstep;
            const char* a3 = a2 + kstep; const char* b3 = b2 + kstep;
            unsigned o2[2][2];
#pragma unroll
            for (int h = 0; h < 2; ++h)
#pragma unroll
                for (int i = 0; i < 2; ++i) o2[h][i] = last ? nxtA[h][i] : curA[h][i];
            PG8_LDB(B0, 0, 0); PG8_LDB(B1, 0, 1); PG8_SCHED; PG8_LDA(At, 0, 0); PG8_STAGE(PG8_SA(1, 1), a1, curA[1]);
            PG8_WAIT_V(8); PG8_WAIT_L(0); PG8_BAR; PG8_MMA(0, 0, At, B0); PG8_MMA(0, 1, At, B1); PG8_BAR; PG8_SCHED;
            PG8_LDA(At, 0, 1); PG8_STAGE(PG8_SB(0, 0), b2, voffB); PG8_STAGE(PG8_SB(0, 1), b2 + hstep, voffB); PG8_STAGE(PG8_SA(0, 0), a2, o2[0]);
            PG8_WAIT_V(8); PG8_WAIT_L(0); PG8_BAR; PG8_MMA(1, 0, At, B0); PG8_MMA(1, 1, At, B1); PG8_BAR; PG8_SCHED;
            PG8_LDB(B0, 1, 0); PG8_LDB(B1, 1, 1); PG8_SCHED; PG8_LDA(At, 1, 0); PG8_STAGE(PG8_SA(0, 1), a2, o2[1]);
            PG8_WAIT_V(8); PG8_WAIT_L(0); PG8_BAR; PG8_MMA(0, 0, At, B0); PG8_MMA(0, 1, At, B1); PG8_BAR; PG8_SCHED;
            PG8_LDA(At, 1, 1); PG8_STAGE(PG8_SB(1, 0), b3, voffB); PG8_STAGE(PG8_SB(1, 1), b3 + hstep, voffB); PG8_STAGE(PG8_SA(1, 0), a3, o2[0]);
            PG8_WAIT_V(8); PG8_WAIT_L(0); PG8_BAR; PG8_MMA(1, 0, At, B0); PG8_MMA(1, 1, At, B1); PG8_BAR; PG8_SCHED;
        }
        if constexpr (ALIGN_EPI) { if (wr == 0) PG8_BAR; }
        E(acc, cur, wr, wc, fr, fq);
        if (!has_next) break;
#pragma unroll
        for (int a = 0; a < 2; ++a)
#pragma unroll
            for (int b = 0; b < 2; ++b)
#pragma unroll
                for (int m = 0; m < 4; ++m)
#pragma unroll
                    for (int n = 0; n < 2; ++n) acc[a][b][m][n] = (f32x4){0.f, 0.f, 0.f, 0.f};
        cur = nxt; cB = nB; ++ui;
#pragma unroll
        for (int h = 0; h < 2; ++h)
#pragma unroll
            for (int i = 0; i < 2; ++i) curA[h][i] = nxtA[h][i];
        if constexpr (ALIGN_EPI) { if (wr == 1) PG8_BAR; }
    }
    PG8_WAIT_V(0);
    if constexpr (!ALIGN_EPI) { if (wr == 0) PG8_BAR; }
    PG8_BAR;
#undef PG8_SA
#undef PG8_SB
#undef PG8_STAGE
#undef PG8_LDA
#undef PG8_LDB
#undef PG8_MMA
#undef PG8_WAIT_V
#undef PG8_WAIT_L
#undef PG8_BAR
#undef PG8_SCHED
}
#endif
}

#define XB_TMO      128
#define XB_XCNT(j)  (256  + 64 * (j))
#define XB_XSUB(j)  (1280 + 64 * (j))
#define XB_XGEN(j)  (2304 + 64 * (j))
#define XB_TOP      3328
#define XB_TOPGEN   3392
#define XCD_BAR_WORDS 3456
#define XB_SPIN_CAP (1u << 18)
__device__ __forceinline__ unsigned xb_ld(unsigned* p)              { return __hip_atomic_load(p, __ATOMIC_RELAXED, __HIP_MEMORY_SCOPE_AGENT); }
__device__ __forceinline__ unsigned xb_add(unsigned* p, unsigned v) { return __hip_atomic_fetch_add(p, v, __ATOMIC_RELAXED, __HIP_MEMORY_SCOPE_AGENT); }
__device__ __forceinline__ unsigned xb_xcc_id() { return (unsigned)__builtin_amdgcn_s_getreg((3 << 11) | 20) & 0xFu; }
#define XB_SPIN(cond, bar) do { unsigned _sp = 0; while (cond) { __builtin_amdgcn_s_sleep(1); \
    if ((++_sp & 255u) == 0u) { if (xb_ld(&(bar)[XB_TMO])) break; if (_sp > XB_SPIN_CAP) { atomicAdd(&(bar)[XB_TMO], 1u); break; } } } } while (0)
struct XcdBarrier { unsigned* bar; unsigned x; volatile LAS unsigned* st; };
__device__ __forceinline__ XcdBarrier xcd_barrier_post(unsigned* bar, volatile LAS unsigned* st) {
    XcdBarrier b; b.bar = bar; b.x = xb_xcc_id(); b.st = st;
    if (threadIdx.x == 0) (void)xb_add(&bar[XB_XCNT(b.x)], 1u);
    return b;
}
__device__ __forceinline__ void xcd_barrier_complete(unsigned* bar, unsigned x, unsigned& nloc, unsigned& nx) {
    const unsigned G = gridDim.x * gridDim.y * gridDim.z;
    unsigned sum, cnt, mine, sp = 0u;
    for (;;) {
        sum = 0u; cnt = 0u; mine = 0u;
#pragma unroll
        for (unsigned j = 0; j < 16; ++j) { const unsigned c = xb_ld(&bar[XB_XCNT(j)]); sum += c; cnt += (c > 0u) ? 1u : 0u; mine = (j == x) ? c : mine; }
        if (sum == G) break;
        __builtin_amdgcn_s_sleep(1);
        if ((++sp & 255u) == 0u) { if (xb_ld(&bar[XB_TMO])) break; if (sp > XB_SPIN_CAP) { atomicAdd(&bar[XB_TMO], 1u); break; } }
    }
    nloc = mine > 0u ? mine : 1u; nx = cnt > 0u ? cnt : 1u;
}
__device__ __forceinline__ void xcd_barrier(const XcdBarrier& b) {
    asm volatile("s_waitcnt vmcnt(0)" ::: "memory");
    __syncthreads();
    if (threadIdx.x == 0) {
        unsigned* bar = b.bar;
        __builtin_amdgcn_s_waitcnt(0);
        unsigned nloc = b.st[0], nx = b.st[1];
        if (nloc == 0u) { xcd_barrier_complete(bar, b.x, nloc, nx); b.st[0] = nloc; b.st[1] = nx; }
        const unsigned old = xb_add(&bar[XB_XSUB(b.x)], 1u);
        const unsigned gen = old / nloc;
        if (old + 1u == (gen + 1u) * nloc) {
            __builtin_amdgcn_fence(__ATOMIC_RELEASE, "agent");
            asm volatile("s_waitcnt vmcnt(0)" ::: "memory");
            const unsigned og = xb_add(&bar[XB_TOP], 1u);
            const unsigned tg = og / nx;
            if (og + 1u == (tg + 1u) * nx) xb_add(&bar[XB_TOPGEN], 1u);
            else XB_SPIN(xb_ld(&bar[XB_TOPGEN]) == tg, bar);
            __builtin_amdgcn_fence(__ATOMIC_ACQUIRE, "agent");
            xb_add(&bar[XB_XGEN(b.x)], 1u);
            asm volatile("s_waitcnt vmcnt(0)" ::: "memory");
        } else {
            XB_SPIN(xb_ld(&bar[XB_XGEN(b.x)]) == gen, bar);
            __builtin_amdgcn_fence(__ATOMIC_ACQUIRE, "agent");
            asm volatile("s_waitcnt vmcnt(0)" ::: "memory");
        }
    }
    __syncthreads();
}

struct Frame {
    LAS unsigned char* lds;
    volatile LAS unsigned* MISC;
    unsigned* ctl;
    int tid, lane, wave, vcu, G;
    const float* in[25]; float* out; unsigned char* ws;
};
enum { I_X = 0, I_WIN, I_CONVW, I_CONVB, I_WRG, I_BRG, I_WIG, I_BIG, I_LAM, I_SINKS, I_GATTN, I_GLRU, I_WOUT, I_LN1G, I_LN1B, I_WROUTER, I_EBIAS, I_WGATE, I_WUP, I_WDOWN, I_WSGATE, I_WSUP, I_WSDOWN, I_LN2G, I_LN2B };

__device__ __forceinline__ float wave_sum(float v) {
#pragma unroll
    for (int o = 1; o < 64; o <<= 1) v += __shfl_xor(v, o);
    return v;
}
#define LDS_WAIT() asm volatile("s_waitcnt lgkmcnt(0)" ::: "memory")

template <class RowMap>
__device__ __forceinline__ void p0_transpose_item(const float* W, int K, int ldw, bf16* WT, const RowMap& rm, LAS float* scr, int item, int lane) {
    const int nblk = ldw / 32, kb = item / nblk, nb = item % nblk, k0 = 64 * kb, n0 = 32 * nb;
#pragma unroll 8
    for (int i = 0; i < 32; ++i) { const int kk = 2 * i + (lane >> 5); scr[kk * 33 + (lane & 31)] = W[(size_t)(k0 + kk) * ldw + n0 + (lane & 31)]; }
    LDS_WAIT(); asm volatile("" ::: "memory");
    const int c = lane & 7;
#pragma unroll
    for (int j = 0; j < 4; ++j) { const int n = (lane >> 3) + 8 * j; const LAS float* s = scr + (8 * c) * 33 + n;
        v4u o; o.x = pk2(s[0 * 33], s[1 * 33]); o.y = pk2(s[2 * 33], s[3 * 33]); o.z = pk2(s[4 * 33], s[5 * 33]); o.w = pk2(s[6 * 33], s[7 * 33]);
        *(v4u*)(WT + (size_t)rm(n0 + n) * K + k0 + 8 * c) = o; }
    LDS_WAIT(); asm volatile("" ::: "memory");
}
struct MapIn {
    __device__ __forceinline__ int operator()(int n) const {
        if (n >= AW + KVW) return n;
        const int d = n & 63, p = 32 * ((d >> 4) & 1) + 8 * ((d >> 2) & 3) + 4 * (d >> 5) + (d & 3);
        return (n & ~63) + p;
    }
};
struct MapId { int off; __device__ __forceinline__ int operator()(int n) const { return off + n; } };
struct MapDown { __device__ __forceinline__ int operator()(int n) const {
        const int lg = n & 255, wc = lg >> 6, fq = (lg >> 4) & 3, bj = (lg >> 3) & 1, nn = (lg >> 2) & 1, j = lg & 3;
        return (n & ~255) + 128 * bj + 32 * wc + 8 * fq + 4 * nn + j; } };
struct MapGU { int up; __device__ __forceinline__ int operator()(int n) const { return (n >> 7) * 256 + up * 128 + (n & 127); } };

__device__ __forceinline__ void p0_prologue(Frame& F) {
    LAS float* scr = (LAS float*)(F.lds + F.wave * 16384);
    const int gw = F.vcu * NWAVES + F.wave, NGW = F.G * NWAVES;
    { bf16* Xb = (bf16*)(F.ws + WS_A1); const float* x = F.in[I_X];
      for (int m = gw; m < S; m += NGW) { const f32x4* xr = (const f32x4*)(x + (size_t)m * D) + F.lane; v2u* o = (v2u*)(Xb + (size_t)m * D) + F.lane;
#pragma unroll
          for (int j = 0; j < 4; ++j) { const f32x4 v = xr[64 * j]; v2u w; w.x = pk2(v.x, v.y); w.y = pk2(v.z, v.w); o[64 * j] = w; } } }
    {
        constexpr int I_IN = (D / 64) * (NIN / 32), I_OUT = (D / 64) * (D / 32), I_G = (D / 64) * (DE / 32), I_DN = (DE / 64) * (D / 32);
        constexpr int PER_E = 2 * I_G + I_DN;
        constexpr int NITEMS = I_IN + I_OUT + NEX * PER_E;
        bf16* WinT = (bf16*)(F.ws + WS_WIN); bf16* WoutT = (bf16*)(F.ws + WS_WOUT); bf16* WguT = (bf16*)(F.ws + WS_WGU); bf16* WdT = (bf16*)(F.ws + WS_WD);
        for (int it = gw; it < NITEMS; it += NGW) {
            int r = it;
            if (r < I_IN) { p0_transpose_item(F.in[I_WIN], D, NIN, WinT, MapIn{}, scr, r, F.lane); continue; } r -= I_IN;
            if (r < I_OUT) { p0_transpose_item(F.in[I_WOUT], D, D, WoutT, MapId{0}, scr, r, F.lane); continue; } r -= I_OUT;
            const int e = r / PER_E; r -= e * PER_E;
            const float* wg = e < NE ? F.in[I_WGATE] + (size_t)e * D * DE : F.in[I_WSGATE];
            const float* wu = e < NE ? F.in[I_WUP] + (size_t)e * D * DE : F.in[I_WSUP];
            const float* wd = e < NE ? F.in[I_WDOWN] + (size_t)e * DE * D : F.in[I_WSDOWN];
            if (r < I_G) { p0_transpose_item(wg, D, DE, WguT + (size_t)e * 512 * D, MapGU{0}, scr, r, F.lane); continue; } r -= I_G;
            if (r < I_G) { p0_transpose_item(wu, D, DE, WguT + (size_t)e * 512 * D, MapGU{1}, scr, r, F.lane); continue; } r -= I_G;
            p0_transpose_item(wd, DE, D, WdT + (size_t)e * D * DE, MapDown{}, scr, r, F.lane);
        }
    }
    {
        const int gt = F.vcu * 512 + F.tid, NGT = F.G * 512;
        float* rc = (float*)(F.ws + WS_ROPEC); float* rs = (float*)(F.ws + WS_ROPES);
        for (int i = gt; i < S * 32; i += NGT) { const int t = i >> 5, f = i & 31;
            const double inv = exp(-(double)f * (9.210340371976184 / 32.0)); const double ang = (double)t * inv;
            rc[i] = (float)cos(ang); rs[i] = (float)sin(ang); }
        int* tok = (int*)(F.ws + WS_TOK);
        for (int i = gt; i < NEX * LCAP; i += NGT) { const bool sh = i >= NE * LCAP; tok[i] = sh ? (i - NE * LCAP) : 0; }
        if (gt == 0) F.ctl[CW_CNT + 16 * NE] = (unsigned)S;
    }
}

struct DenseOrder {
    int nM, nN, nwg, G, c, K2; const char* Bt;
    __device__ void init(int M, int N, int K, const void* Bt_, int G_, int c_) { nM = M / 256; nN = N / 256; nwg = nM * nN; G = G_; c = c_; K2 = K * 2; Bt = (const char*)Bt_; }
    __device__ __forceinline__ bool next(int i, pg8::Unit& u) const {
        const long L = (long)i * G + c; if (L >= nwg) return false;
        int wgid = (int)L; { const int q = nwg / 8, r = nwg % 8, xcd = wgid % 8, off = wgid / 8; wgid = (xcd < r ? xcd * (q + 1) : r * (q + 1) + (xcd - r) * q) + off; }
        const int nig = 8 * nN, gid = wgid / nig, fm = gid * 8, gsz = (nM - fm) < 8 ? (nM - fm) : 8;
        const int pm = fm + ((wgid % nig) % gsz), pn = (wgid % nig) / gsz;
        u.B = Bt + (size_t)pn * 256 * K2; u.row0 = pm * 256; u.slot0 = 0; u.pn = pn; u.e = 0; u.cnt = 256; u.y0 = 0; return true;
    }
    __device__ __forceinline__ unsigned aoff(const pg8::Unit& u, int r) const { return (unsigned)(u.row0 + r) * (unsigned)K2; }
};
struct MoeOrder {
    const LAS int* tb; const LAS int* cl; const LAS int* rb; const int* tok; const char* Bt; size_t bstride_e, bstride_pn; int npn, G, c, total, K2; bool gather;
    __device__ __forceinline__ bool next(int i, pg8::Unit& u) const {
        const int L = i * G + c; if (L >= total) return false;
        const int pn = L % npn, T = L / npn;
        int e = 0;
        for (int s = 32; s >= 1; s >>= 1) { const int e2 = e + s; if (e2 <= NE && __builtin_amdgcn_readfirstlane(tb[e2]) <= T) e = e2; }
        if (e + 1 <= NE && __builtin_amdgcn_readfirstlane(tb[e + 1]) <= T) e = e + 1;
        const int j = T - __builtin_amdgcn_readfirstlane(tb[e]);
        u.e = e; u.pn = pn; u.row0 = T * 256; u.slot0 = e * LCAP + j * 256; u.cnt = __builtin_amdgcn_readfirstlane(cl[e]) - j * 256; u.y0 = __builtin_amdgcn_readfirstlane(rb[e]) + j * 256;
        u.B = Bt + (size_t)e * bstride_e + (size_t)pn * bstride_pn; return true;
    }
    __device__ __forceinline__ unsigned aoff(const pg8::Unit& u, int r) const {
        if (gather) return (unsigned)tok[u.slot0 + r] * (unsigned)K2;
        return (unsigned)(u.row0 + r) * (unsigned)K2;
    }
};

struct EpiInProj {
    static constexpr bool PERM = true;
    bf16 *Q, *Kb, *V, *XR, *YG; const float *rc, *rs;
    __device__ __forceinline__ void operator()(const f32x4 (&acc)[2][2][4][2], const pg8::Unit& u, int wr, int wc, int fr, int fq) const {
        const int pn = u.pn;
#pragma unroll
        for (int ai = 0; ai < 2; ++ai)
#pragma unroll
            for (int m = 0; m < 4; ++m) {
                const size_t row = (size_t)(u.row0 + ai * 128 + wr * 64 + m * 16 + fr);
#pragma unroll
                for (int bj = 0; bj < 2; ++bj) {
                    const f32x4 v0 = acc[ai][bj][m][0], v1 = acc[ai][bj][m][1];
                    if (pn < 2 || (pn == 2 && bj == 0)) {
                        const int d0 = 16 * (wc & 1) + 4 * fq;
                        const f32x4 c = *(const f32x4*)(rc + row * 32 + d0), s = *(const f32x4*)(rs + row * 32 + d0);
                        f32x4 o1 = v0 * c - v1 * s, o2 = v1 * c + v0 * s;
                        bf16* dst;
                        if (pn < 2) { o1 = o1 * 0.125f; o2 = o2 * 0.125f; dst = Q + row * AW + pn * 256 + bj * 128 + (wc >> 1) * 64; }
                        else dst = Kb + row * KVW + (wc >> 1) * 64;
                        v2u w1, w2; w1.x = pg8::cvt_pk_bf16(o1[0], o1[1]); w1.y = pg8::cvt_pk_bf16(o1[2], o1[3]); w2.x = pg8::cvt_pk_bf16(o2[0], o2[1]); w2.y = pg8::cvt_pk_bf16(o2[2], o2[3]);
                        *(v2u*)(dst + d0) = w1; *(v2u*)(dst + 32 + d0) = w2;
                    } else {
                        bf16* dst;
                        if (pn == 2) dst = V + row * KVW + wc * 32 + 8 * fq;
                        else if (pn < 5) dst = XR + row * LW + (pn - 3) * 256 + bj * 128 + wc * 32 + 8 * fq;
                        else dst = YG + row * LW + (pn - 5) * 256 + bj * 128 + wc * 32 + 8 * fq;
                        v4u w; w.x = pg8::cvt_pk_bf16(v0[0], v0[1]); w.y = pg8::cvt_pk_bf16(v0[2], v0[3]); w.z = pg8::cvt_pk_bf16(v1[0], v1[1]); w.w = pg8::cvt_pk_bf16(v1[2], v1[3]);
                        *(v4u*)dst = w;
                    }
                }
            }
    }
};
struct EpiZ {
    static constexpr bool PERM = false;
    float* Z; const float* x;
    __device__ __forceinline__ void operator()(const f32x4 (&acc)[2][2][4][2], const pg8::Unit& u, int wr, int wc, int fr, int fq) const {
#pragma unroll
        for (int ai = 0; ai < 2; ++ai)
#pragma unroll
            for (int m = 0; m < 4; ++m) {
                const size_t off = (size_t)(u.row0 + ai * 128 + wr * 64 + m * 16 + fr) * D + u.pn * 256 + wc * 32 + 4 * fq;
#pragma unroll
                for (int bj = 0; bj < 2; ++bj)
#pragma unroll
                    for (int n = 0; n < 2; ++n) { const f32x4 xv = *(const f32x4*)(x + off + bj * 128 + n * 16); *(f32x4*)(Z + off + bj * 128 + n * 16) = acc[ai][bj][m][n] + xv * ALPHA; }
            }
    }
};
__device__ __forceinline__ float silu_mul(float g, float u) { return g * u * __builtin_amdgcn_rcpf(1.0f + fast_exp(-g)); }
struct EpiAct {
    static constexpr bool PERM = true;
    bf16* ACT;
    __device__ __forceinline__ void operator()(const f32x4 (&acc)[2][2][4][2], const pg8::Unit& u, int wr, int wc, int fr, int fq) const {
#pragma unroll
        for (int ai = 0; ai < 2; ++ai)
#pragma unroll
            for (int m = 0; m < 4; ++m) {
                const size_t row = (size_t)(u.row0 + ai * 128 + wr * 64 + m * 16 + fr);
                const f32x4 g0 = acc[ai][0][m][0], g1 = acc[ai][0][m][1], u0 = acc[ai][1][m][0], u1 = acc[ai][1][m][1];
                v4u w;
                w.x = pg8::cvt_pk_bf16(silu_mul(g0[0], u0[0]), silu_mul(g0[1], u0[1])); w.y = pg8::cvt_pk_bf16(silu_mul(g0[2], u0[2]), silu_mul(g0[3], u0[3]));
                w.z = pg8::cvt_pk_bf16(silu_mul(g1[0], u1[0]), silu_mul(g1[1], u1[1])); w.w = pg8::cvt_pk_bf16(silu_mul(g1[2], u1[2]), silu_mul(g1[3], u1[3]));
                *(v4u*)(ACT + row * DE + u.pn * 128 + wc * 32 + 8 * fq) = w;
            }
    }
};
struct EpiY8 {
    static constexpr bool PERM = true;
    unsigned char* Y; float* out;
    __device__ __forceinline__ void operator()(const f32x4 (&acc)[2][2][4][2], const pg8::Unit& u, int wr, int wc, int fr, int fq) const {
        const int colb = u.pn * 256 + 64 * wc + 16 * fq;
        if (u.e == NE) {
#pragma unroll
            for (int ai = 0; ai < 2; ++ai)
#pragma unroll
                for (int m = 0; m < 4; ++m) {
                    const int r = ai * 128 + wr * 64 + m * 16 + fr;
                    float* o = out + (size_t)((u.slot0 - NE * LCAP) + r) * D + colb;
#pragma unroll
                    for (int bj = 0; bj < 2; ++bj)
#pragma unroll
                        for (int n = 0; n < 2; ++n) { f32x4 v = *(f32x4*)(o + 8 * bj + 4 * n); v = v + acc[ai][bj][m][n]; *(f32x4*)(o + 8 * bj + 4 * n) = v; }
                    asm volatile("" ::: "memory");
                }
        } else {
#pragma unroll
            for (int ai = 0; ai < 2; ++ai)
#pragma unroll
                for (int m = 0; m < 4; ++m) {
                    const int r = ai * 128 + wr * 64 + m * 16 + fr;
                    if (r < u.cnt) {
                        v4u w;
#pragma unroll
                        for (int bj = 0; bj < 2; ++bj)
#pragma unroll
                            for (int n = 0; n < 2; ++n) { const f32x4 v = acc[ai][bj][m][n] * 64.0f; int p = 0;
                                p = __builtin_amdgcn_cvt_pk_fp8_f32(v[0], v[1], p, false); p = __builtin_amdgcn_cvt_pk_fp8_f32(v[2], v[3], p, true); w[2 * bj + n] = (unsigned)p; }
                        *(v4u*)(Y + (size_t)(u.y0 + r) * D + colb) = w;
                    }
                }
        }
    }
};

__device__ __forceinline__ void attn_unit(Frame& F, int t0) {
    LAS bf16* Kl = (LAS bf16*)F.lds; LAS bf16* Vl = (LAS bf16*)(F.lds + 49152); LAS float* red = (LAS float*)(F.lds + 98304);
    const bf16* Qb = (const bf16*)(F.ws + WS_A2 + U_Q); const bf16* Kb = (const bf16*)(F.ws + WS_A2 + U_K); const bf16* Vb = (const bf16*)(F.ws + WS_A2 + U_V);
    bf16* MIX = (bf16*)(F.ws + WS_A1);
    for (int p = F.tid; p < 2 * 3072; p += 512) {
        const int which = p / 3072, q = p % 3072, kv = q / 1536, r = (q % 1536) / 8, ch = q % 8, kj = t0 - 128 + r;
        v4u val = (v4u){0u, 0u, 0u, 0u};
        if (kj >= 0) val = *(const v4u*)((which ? Vb : Kb) + (size_t)kj * KVW + kv * 64 + ch * 8);
        *(LAS v4u*)((which ? Vl : Kl) + (kv * 192 + r) * 64 + ch * 8) = val;
    }
    __syncthreads();
    const int h = F.wave, kv = h >> 2, t = t0 + F.lane;
    float q[64], o[64];
    { const v4u* qp = (const v4u*)(Qb + (size_t)t * AW + h * 64);
#pragma unroll
      for (int c = 0; c < 8; ++c) { const v4u v = qp[c];
#pragma unroll
          for (int k = 0; k < 4; ++k) { q[c * 8 + 2 * k] = bf2f(v[k] & 0xffffu); q[c * 8 + 2 * k + 1] = bf2f(v[k] >> 16); } } }
#pragma unroll
    for (int d = 0; d < 64; ++d) o[d] = 0.f;
    float mrun = F.in[I_SINKS][h], l = 1.0f;
    for (int j = 1; j < 192; ++j) {
        const bool valid = (j >= F.lane + 1) && (j <= F.lane + 128) && (t0 - 128 + j >= 0);
        const LAS v4u* kp = (const LAS v4u*)(Kl + (kv * 192 + j) * 64);
        float s = 0.f;
#pragma unroll
        for (int c = 0; c < 8; ++c) { const v4u v = kp[c];
#pragma unroll
            for (int k = 0; k < 4; ++k) { s += q[c * 8 + 2 * k] * bf2f(v[k] & 0xffffu); s += q[c * 8 + 2 * k + 1] * bf2f(v[k] >> 16); } }
        float al = 1.f, pw = 0.f;
        if (valid) { const float mn = fmaxf(mrun, s); al = fast_exp(mrun - mn); pw = fast_exp(s - mn); mrun = mn; }
        l = l * al + pw;
        const LAS v4u* vp = (const LAS v4u*)(Vl + (kv * 192 + j) * 64);
#pragma unroll
        for (int c = 0; c < 8; ++c) { const v4u v = vp[c];
#pragma unroll
            for (int k = 0; k < 4; ++k) { o[c * 8 + 2 * k] = o[c * 8 + 2 * k] * al + pw * bf2f(v[k] & 0xffffu); o[c * 8 + 2 * k + 1] = o[c * 8 + 2 * k + 1] * al + pw * bf2f(v[k] >> 16); } }
    }
    const float inv = 1.0f / l; float ssq = 0.f;
#pragma unroll
    for (int d = 0; d < 64; ++d) { o[d] *= inv; ssq += o[d] * o[d]; }
    red[h * 64 + F.lane] = ssq;
    __syncthreads();
    float tot = 0.f;
#pragma unroll
    for (int hh = 0; hh < 8; ++hh) tot += red[hh * 64 + F.lane];
    const float rsn = 1.0f / sqrtf(tot * (1.0f / AW) + NORM_EPS);
    const float* ga = F.in[I_GATTN] + h * 64;
    v4u* dst = (v4u*)(MIX + (size_t)t * D + h * 64);
#pragma unroll
    for (int c = 0; c < 8; ++c) { v4u w;
#pragma unroll
        for (int k = 0; k < 4; ++k) w[k] = pk2(o[c * 8 + 2 * k] * rsn * ga[c * 8 + 2 * k], o[c * 8 + 2 * k + 1] * rsn * ga[c * 8 + 2 * k + 1]);
        dst[c] = w; }
    __syncthreads();
}
__device__ __forceinline__ void lru_local_unit(Frame& F, int chunk) {
    LAS float* xcl = (LAS float*)F.lds;
    const int t0 = chunk * 64, c = F.tid, n = c >> 6, j = c & 63;
    const bf16* XR = (const bf16*)(F.ws + WS_A2 + U_XR);
    float* HL = F.out; float* PL = F.out + (size_t)S * LW;
    const float* cw = F.in[I_CONVW]; const float w0 = cw[c], w1 = cw[LW + c], w2 = cw[2 * LW + c], w3 = cw[3 * LW + c], cb = F.in[I_CONVB][c];
    float x0 = t0 >= 3 ? bf2f(XR[(size_t)(t0 - 3) * LW + c]) : 0.f, x1 = t0 >= 2 ? bf2f(XR[(size_t)(t0 - 2) * LW + c]) : 0.f, x2 = t0 >= 1 ? bf2f(XR[(size_t)(t0 - 1) * LW + c]) : 0.f;
#pragma unroll 4
    for (int tl = 0; tl < 64; ++tl) { const float x3 = bf2f(XR[(size_t)(t0 + tl) * LW + c]);
        xcl[tl * 512 + c] = cb + w0 * x0 + w1 * x1 + w2 * x2 + w3 * x3; x0 = x1; x1 = x2; x2 = x3; }
    __syncthreads();
    float wrg[64], wig[64];
    { const float* a = F.in[I_WRG] + (size_t)n * 4096 + j; const float* b = F.in[I_WIG] + (size_t)n * 4096 + j;
      asm volatile("" : "+v"(a), "+v"(b));
#pragma unroll
      for (int i = 0; i < 64; ++i) { wrg[i] = a[i * 64]; wig[i] = b[i * 64]; } }
    const float brg = F.in[I_BRG][c], big = F.in[I_BIG][c];
    const float lam = F.in[I_LAM][c]; const float sp = log1pf(expf(-lam));
    float hrun = 0.f, prun = 1.f;
#pragma unroll 1
    for (int tl = 0; tl < 64; ++tl) {
        float ar = brg, ai = big;
        const LAS f32x4* xp = (const LAS f32x4*)(xcl + tl * 512 + n * 64);
#pragma unroll
        for (int i4 = 0; i4 < 16; ++i4) { const f32x4 xv = xp[i4];
#pragma unroll
            for (int k = 0; k < 4; ++k) { ar += xv[k] * wrg[i4 * 4 + k]; ai += xv[k] * wig[i4 * 4 + k]; } }
        const float r = sigmoidf_(ar), ig = sigmoidf_(ai);
        const float log_a = -8.0f * r * sp; const float a = expf(log_a);
        const float mult = sqrtf(-expm1f(2.0f * log_a));
        const float inp = mult * (ig * xcl[tl * 512 + c]);
        hrun = a * hrun + inp; prun *= a;
        HL[(size_t)(t0 + tl) * LW + c] = hrun; PL[(size_t)(t0 + tl) * LW + c] = prun;
    }
    float* agg = (float*)(F.ws + WS_AGG);
    *(f32x2*)(agg + ((size_t)chunk * LW + c) * 2) = (f32x2){prun, hrun};
    __syncthreads();
}
__device__ __forceinline__ float gelu_tanh(float x) { const float u = 0.7978845608028654f * (x + 0.044715f * x * x * x); const float e = fast_exp(2.0f * u); return 0.5f * x * (1.0f + (1.0f - 2.0f / (e + 1.0f))); }
__device__ __forceinline__ void lru_fix_unit(Frame& F, int chunk) {
    LAS float* part = (LAS float*)F.lds;
    const int t0 = chunk * 64, c = F.tid;
    const float* agg = (const float*)(F.ws + WS_AGG);
    float carry = 0.f;
    for (int k = 0; k < chunk; ++k) { const f32x2 a = *(const f32x2*)(agg + ((size_t)k * LW + c) * 2); carry = a.x * carry + a.y; }
    const float* HL = F.out; const float* PL = F.out + (size_t)S * LW;
    const bf16* YG = (const bf16*)(F.ws + WS_A2 + U_YG);
    float y[64];
#pragma unroll
    for (int tl = 0; tl < 64; ++tl) { const size_t o = (size_t)(t0 + tl) * LW + c; const float hv = HL[o] + PL[o] * carry; y[tl] = gelu_tanh(bf2f(YG[o])) * hv; }
#pragma unroll
    for (int tl = 0; tl < 64; ++tl) { const float s = wave_sum(y[tl] * y[tl]); if (F.lane == 0) part[tl * 8 + F.wave] = s; }
    __syncthreads();
    const float g = F.in[I_GLRU][c];
    bf16* MIX = (bf16*)(F.ws + WS_A1);
#pragma unroll
    for (int tl = 0; tl < 64; ++tl) { float tot = 0.f;
#pragma unroll
        for (int w = 0; w < 8; ++w) tot += part[tl * 8 + w];
        const float rsn = 1.0f / sqrtf(tot * (1.0f / LW) + NORM_EPS);
        MIX[(size_t)(t0 + tl) * D + AW + c] = (bf16)f2bf(y[tl] * rsn * g); }
    __syncthreads();
}
__device__ __forceinline__ void route_unit(Frame& F, int unit) {
    LAS float* hrow = (LAS float*)F.lds;
    LAS float* lg = (LAS float*)(F.lds + SCR_OFF);
    LAS float* sc = lg + 32 * 65;
    const int t0 = unit * 32;
    const float* Z = (const float*)(F.ws + WS_A2);
    bf16* H1b = (bf16*)(F.ws + WS_A1);
    const float* g1 = F.in[I_LN1G]; const float* b1 = F.in[I_LN1B];
    for (int rr = 0; rr < 4; ++rr) {
        const int tl = F.wave * 4 + rr; const size_t row = (size_t)(t0 + tl);
        const f32x4* zr = (const f32x4*)(Z + row * D) + F.lane;
        f32x4 v[4]; float s = 0.f;
#pragma unroll
        for (int j = 0; j < 4; ++j) { v[j] = zr[64 * j]; s += (v[j].x + v[j].y) + (v[j].z + v[j].w); }
        const float mean = wave_sum(s) * (1.f / D); float s2 = 0.f;
#pragma unroll
        for (int j = 0; j < 4; ++j) { v[j] = v[j] - mean; s2 += (v[j].x * v[j].x + v[j].y * v[j].y) + (v[j].z * v[j].z + v[j].w * v[j].w); }
        const float rstd = 1.f / sqrtf(wave_sum(s2) * (1.f / D) + NORM_EPS);
#pragma unroll
        for (int j = 0; j < 4; ++j) {
            const f32x4 gg = *((const f32x4*)g1 + F.lane + 64 * j), bb = *((const f32x4*)b1 + F.lane + 64 * j);
            const f32x4 hv = v[j] * rstd * gg + bb;
            *((LAS f32x4*)(hrow + tl * 1024) + F.lane + 64 * j) = hv;
            *((f32x4*)(F.out + row * D) + F.lane + 64 * j) = hv * ALPHA;
            v2u w; w.x = pk2(hv.x, hv.y); w.y = pk2(hv.z, hv.w); *((v2u*)(H1b + row * D) + F.lane + 64 * j) = w;
        }
    }
    __syncthreads();
    {
        const float* wr_ = F.in[I_WROUTER] + F.lane;
        float a0 = 0.f, a1 = 0.f, a2 = 0.f, a3 = 0.f;
        const LAS f32x4* h0 = (const LAS f32x4*)(hrow + (F.wave * 4 + 0) * 1024); const LAS f32x4* h1 = (const LAS f32x4*)(hrow + (F.wave * 4 + 1) * 1024);
        const LAS f32x4* h2 = (const LAS f32x4*)(hrow + (F.wave * 4 + 2) * 1024); const LAS f32x4* h3 = (const LAS f32x4*)(hrow + (F.wave * 4 + 3) * 1024);
        for (int k4 = 0; k4 < 256; ++k4) {
            const f32x4 x0 = h0[k4], x1 = h1[k4], x2 = h2[k4], x3 = h3[k4];
#pragma unroll
            for (int k = 0; k < 4; ++k) { const float w = wr_[(size_t)(k4 * 4 + k) * NE]; a0 += x0[k] * w; a1 += x1[k] * w; a2 += x2[k] * w; a3 += x3[k] * w; }
        }
        const float eb = F.in[I_EBIAS][F.lane];
        const float s0 = sigmoidf_(a0), s1 = sigmoidf_(a1), s2 = sigmoidf_(a2), s3 = sigmoidf_(a3);
        const int tb = F.wave * 4;
        sc[(tb + 0) * 65 + F.lane] = s0; sc[(tb + 1) * 65 + F.lane] = s1; sc[(tb + 2) * 65 + F.lane] = s2; sc[(tb + 3) * 65 + F.lane] = s3;
        lg[(tb + 0) * 65 + F.lane] = s0 + eb; lg[(tb + 1) * 65 + F.lane] = s1 + eb; lg[(tb + 2) * 65 + F.lane] = s2 + eb; lg[(tb + 3) * 65 + F.lane] = s3 + eb;
    }
    __syncthreads();
    if (F.tid < 32) {
        const int tl = F.tid, t = t0 + tl;
        LAS float* L = lg + tl * 65; const LAS float* Sc = sc + tl * 65;
        float gs[8];
#pragma unroll
        for (int g = 0; g < 8; ++g) { float m1 = -INFINITY, m2 = -INFINITY;
            for (int i = 0; i < 8; ++i) { const float v = L[g * 8 + i]; if (v > m1) { m2 = m1; m1 = v; } else if (v > m2) m2 = v; }
            gs[g] = m1 + m2; }
        unsigned gsel = 0;
#pragma unroll
        for (int r = 0; r < 4; ++r) { int bg = 0; float bv = -INFINITY;
#pragma unroll
            for (int g = 0; g < 8; ++g) if (!((gsel >> g) & 1u) && gs[g] > bv) { bv = gs[g]; bg = g; }
            gsel |= 1u << bg; }
        int idx[8]; float w[8]; float wsum = 0.f;
#pragma unroll
        for (int k = 0; k < 8; ++k) { int be = 0; float bv = -INFINITY;
            for (int e = 0; e < NE; ++e) if ((gsel >> (e >> 3)) & 1u) { const float v = L[e]; if (v > bv) { bv = v; be = e; } }
            L[be] = -INFINITY; idx[k] = be; w[k] = Sc[be]; wsum += w[k]; }
        const float scale = 2.5f / wsum;
        int* tok = (int*)(F.ws + WS_TOK); int* rie = (int*)(F.ws + WS_RIE) + (size_t)t * 8; float* riw = (float*)(F.ws + WS_RIW) + (size_t)t * 8;
        unsigned slot[8];
#pragma unroll
        for (int k = 0; k < 8; ++k) slot[k] = atomicAdd(F.ctl + CW_CNT + 16 * idx[k], 1u);
#pragma unroll
        for (int k = 0; k < 8; ++k) { tok[idx[k] * LCAP + slot[k]] = t; rie[k] = idx[k] | (int)(slot[k] << 8); riw[k] = w[k] * scale; }
    }
    __syncthreads();
}
__device__ __forceinline__ void combine_rows(Frame& F, const LAS int* rb) {
    const int gw = F.vcu * NWAVES + F.wave, NGW = F.G * NWAVES;
    const float* g2 = F.in[I_LN2G]; const float* b2 = F.in[I_LN2B];
    const unsigned char* Y = F.ws + WS_Y8; const int* rie = (const int*)(F.ws + WS_RIE); const float* riw = (const float*)(F.ws + WS_RIW);
    for (int m = gw; m < S; m += NGW) {
        f32x4* xr = (f32x4*)(F.out + (size_t)m * D) + F.lane * 4;
        f32x4 v[4];
#pragma unroll
        for (int j = 0; j < 4; ++j) v[j] = xr[j];
        const int ek = rie[(size_t)m * 8 + (F.lane & 7)]; const float wk = riw[(size_t)m * 8 + (F.lane & 7)] * (1.0f / 64.0f);
#pragma unroll
        for (int k = 0; k < 8; ++k) {
            const int ee = __builtin_amdgcn_readlane(ek, k); const float ww = __int_as_float(__builtin_amdgcn_readlane(__float_as_int(wk), k));
            const int row = rb[ee & 255] + (ee >> 8);
            const v4u y = *(const v4u*)(Y + (size_t)row * D + F.lane * 16);
#pragma unroll
            for (int j = 0; j < 4; ++j) { const f32x2 a = __builtin_amdgcn_cvt_pk_f32_fp8((int)y[j], false), b = __builtin_amdgcn_cvt_pk_f32_fp8((int)y[j], true);
                v[j].x += ww * a.x; v[j].y += ww * a.y; v[j].z += ww * b.x; v[j].w += ww * b.y; }
        }
        float s = 0.f;
#pragma unroll
        for (int j = 0; j < 4; ++j) s += (v[j].x + v[j].y) + (v[j].z + v[j].w);
        const float mean = wave_sum(s) * (1.f / D); float s2 = 0.f;
#pragma unroll
        for (int j = 0; j < 4; ++j) { v[j] = v[j] - mean; s2 += (v[j].x * v[j].x + v[j].y * v[j].y) + (v[j].z * v[j].z + v[j].w * v[j].w); }
        const float rstd = 1.f / sqrtf(wave_sum(s2) * (1.f / D) + NORM_EPS);
#pragma unroll
        for (int j = 0; j < 4; ++j) { const f32x4 gg = *((const f32x4*)g2 + F.lane * 4 + j), bb = *((const f32x4*)b2 + F.lane * 4 + j); xr[j] = v[j] * rstd * gg + bb; }
    }
}
__device__ __forceinline__ void moe_table(Frame& F, LAS int* tb, LAS int* cl, LAS int* rb) {
    if (F.tid == 0) { int acc = 0, racc = 0; for (int e = 0; e < NEX; ++e) { const int c = (int)F.ctl[CW_CNT + 16 * e]; cl[e] = c; tb[e] = acc; rb[e] = racc; acc += (c + 255) >> 8; racc += c; } tb[NEX] = acc; rb[NEX] = racc; }
    __syncthreads();
}

struct Args { const float* in[25]; float* out; unsigned char* ws; int ph_lo, ph_hi, li, pad; };
__global__ void __launch_bounds__(NWAVES * 64, 2) fwd(Args args) {
    extern __shared__ __attribute__((aligned(16))) unsigned char lds[];
    Frame F;
    F.lds = (LAS unsigned char*)lds;
    F.MISC = (volatile LAS unsigned*)(F.lds + MISC_OFF);
    F.tid = threadIdx.x; F.lane = F.tid & 63; F.wave = __builtin_amdgcn_readfirstlane(F.tid >> 6);
    F.G = gridDim.x; { const int bx = blockIdx.x; F.vcu = (F.G % 8 == 0) ? (bx % 8) * (F.G / 8) + bx / 8 : bx; }
    F.ws = args.ws; F.out = args.out; F.ctl = (unsigned*)(args.ws + WS_CTL);
#pragma unroll
    for (int i = 0; i < 25; ++i) F.in[i] = args.in[i];
    for (int u = F.tid; u < 128; u += NWAVES * 64) ((LAS unsigned*)(F.lds + MISC_OFF))[u] = 0u;
    __syncthreads();
    XcdBarrier bar; bar.bar = F.ctl + CW_BAR; bar.x = 0; bar.st = nullptr;
    if (MK_N_LAUNCHES == 1) bar = xcd_barrier_post(F.ctl + CW_BAR, F.MISC + 8);
    const int lo = args.ph_lo, hi = args.ph_hi;
#ifndef PH_MASK
#define PH_MASK 0x1ff
#endif
#define IN(k) (((PH_MASK >> (k)) & 1) && lo <= (k) && (k) < hi)
#define BOTH(k) (IN(k) && IN((k) + 1))
#define GRID_BAR() do { if (MK_N_LAUNCHES == 1) xcd_barrier(bar); } while (0)

    if (IN(0)) { p0_prologue(F); if (BOTH(0)) GRID_BAR(); }
    if (IN(1)) {
        DenseOrder So; So.init(S, NIN, D, F.ws + WS_WIN, F.G, (int)blockIdx.x);
        EpiInProj E{(bf16*)(F.ws + WS_A2 + U_Q), (bf16*)(F.ws + WS_A2 + U_K), (bf16*)(F.ws + WS_A2 + U_V), (bf16*)(F.ws + WS_A2 + U_XR), (bf16*)(F.ws + WS_A2 + U_YG), (const float*)(F.ws + WS_ROPEC), (const float*)(F.ws + WS_ROPES)};
        pg8::gemm_phase<EpiInProj, DenseOrder, true>(F.lds, (const char*)(F.ws + WS_A1), D, So, E);
        if (BOTH(1)) GRID_BAR();
    }
    if (IN(2)) {
        for (int u = F.vcu; u < S / 64; u += F.G) { attn_unit(F, u * 64); lru_local_unit(F, u); }
        if (BOTH(2)) GRID_BAR();
    }
    if (IN(3)) {
        for (int u = F.vcu; u < S / 64; u += F.G) lru_fix_unit(F, u);
        if (BOTH(3)) GRID_BAR();
    }
    if (IN(4)) {
        DenseOrder So; So.init(S, D, D, F.ws + WS_WOUT, F.G, (int)blockIdx.x);
        EpiZ E{(float*)(F.ws + WS_A2), F.in[I_X]};
        pg8::gemm_phase<EpiZ, DenseOrder, true>(F.lds, (const char*)(F.ws + WS_A1), D, So, E);
        if (BOTH(4)) GRID_BAR();
    }
    if (IN(5)) {
        for (int u = F.vcu; u < S / 32; u += F.G) route_unit(F, u);
        if (BOTH(5)) GRID_BAR();
    }
    if (IN(6)) {
        LAS int* tb = (LAS int*)(F.lds + SCR_OFF); LAS int* cl = tb + 128; LAS int* rb = tb + 256;
        moe_table(F, tb, cl, rb);
        MoeOrder So{tb, cl, rb, (const int*)(F.ws + WS_TOK), (const char*)(F.ws + WS_WGU), (size_t)512 * D * 2, (size_t)256 * D * 2, 2, F.G, F.vcu, tb[NEX] * 2, D * 2, true};
        EpiAct E{(bf16*)(F.ws + WS_A2)};
        pg8::gemm_phase<EpiAct, MoeOrder, true>(F.lds, (const char*)(F.ws + WS_A1), D, So, E);
        if (BOTH(6)) GRID_BAR();
    }
    if (IN(7)) {
        LAS int* tb = (LAS int*)(F.lds + SCR_OFF); LAS int* cl = tb + 128; LAS int* rb = tb + 256;
        moe_table(F, tb, cl, rb);
        MoeOrder So{tb, cl, rb, (const int*)(F.ws + WS_TOK), (const char*)(F.ws + WS_WD), (size_t)D * DE * 2, (size_t)256 * DE * 2, 4, F.G, F.vcu, tb[NEX] * 4, DE * 2, false};
        EpiY8 E{F.ws + WS_Y8, F.out};
        pg8::gemm_phase<EpiY8, MoeOrder, true>(F.lds, (const char*)(F.ws + WS_A2), DE, So, E);
        if (BOTH(7)) GRID_BAR();
    }
    if (IN(8)) {
        LAS int* tb = (LAS int*)(F.lds + SCR_OFF); LAS int* cl = tb + 128; LAS int* rb = tb + 256;
        moe_table(F, tb, cl, rb);
        combine_rows(F, rb);
    }
#undef IN
#undef BOTH
#undef GRID_BAR
}

extern "C" void kernel_launch(void* const* d_in, const int* in_sizes, int n_in, void* d_out, int out_size, void* d_ws, size_t ws_size, hipStream_t stream) {
    static int grid = 0;
    if (grid == 0) {
        if (n_in != 25 || out_size != S * D || ws_size < WS_END) { fprintf(stderr, "kernel_launch: unexpected shapes (n_in %d out %d ws %zu)\n", n_in, out_size, ws_size); grid = -1; return; }
        int dev = 0, cus = 0, per_cu = 0;
        if (hipGetDevice(&dev) != hipSuccess || hipDeviceGetAttribute(&cus, hipDeviceAttributeMultiprocessorCount, dev) != hipSuccess) { grid = -1; return; }
        if (hipFuncSetAttribute((const void*)fwd, hipFuncAttributeMaxDynamicSharedMemorySize, LDS_BYTES) != hipSuccess) { fprintf(stderr, "kernel_launch: hipFuncSetAttribute failed\n"); grid = -1; return; }
        if (hipOccupancyMaxActiveBlocksPerMultiprocessor(&per_cu, (const void*)fwd, NWAVES * 64, LDS_BYTES) != hipSuccess || per_cu < 1) fprintf(stderr, "kernel_launch: occupancy query says %d\n", per_cu);
        (void)hipGetLastError();
        grid = cus;
    }
    if (grid < 0) return;
    if (hipMemsetAsync((char*)d_ws + WS_CTL, 0, CTL_ZERO_BYTES, stream) != hipSuccess) return;
    Args a{};
    for (int i = 0; i < 25; ++i) a.in[i] = (const float*)d_in[i];
    a.out = (float*)d_out; a.ws = (unsigned char*)d_ws;
    for (int li = 0; li < MK_N_LAUNCHES; ++li) {
        a.ph_lo = (MK_N_LAUNCHES == 1) ? 0 : li; a.ph_hi = (MK_N_LAUNCHES == 1) ? NPHASE : li + 1; a.li = li;
        hipLaunchKernelGGL(fwd, dim3(grid), dim3(NWAVES * 64), LDS_BYTES, stream, a);
    }
}
```

```cpp
#include <hip/hip_runtime.h>
#include <cstdio>
#include <cstdint>

#ifndef MK_N_LAUNCHES
#define MK_N_LAUNCHES 1
#endif
#ifndef GEMM_REF
#define GEMM_REF 0
#endif

#define LAS __attribute__((address_space(3)))
#define GAS __attribute__((address_space(1)))
typedef unsigned short bf16;
typedef unsigned v4u __attribute__((ext_vector_type(4)));
typedef unsigned v2u __attribute__((ext_vector_type(2)));
typedef float f32x4 __attribute__((ext_vector_type(4)));
typedef float f32x2 __attribute__((ext_vector_type(2)));
typedef short bf16x8 __attribute__((ext_vector_type(8)));

constexpr int S = 16384, D = 1024, NIN = 1792, AW = 512, KVW = 128, LW = 512, NE = 64, NEX = 65, DE = 256, TOPK = 8;
constexpr int LCAP = 16384;
constexpr float ALPHA = 1.18920711500272f;
constexpr float NORM_EPS = 1e-5f;
constexpr float LOG2E = 1.44269504089f;
constexpr float QSCALE = 0.125f * 1.44269504089f;
constexpr int NWAVES = 8;
constexpr int NPHASE = 9;

constexpr size_t MiB = 1u << 20;
constexpr size_t WS_CTL = 0, CTL_ZERO_BYTES = 1 * MiB;
constexpr size_t WS_ROPEC = 1 * MiB, WS_ROPES = 3 * MiB;
constexpr size_t WS_AGG = 12 * MiB;
constexpr size_t WS_GW = 15 * MiB;
constexpr size_t WS_WRH = 15 * MiB + 512 * 1024, WS_WRL = 15 * MiB + 768 * 1024;
constexpr int CW_TMO2 = 8;
constexpr size_t WS_RIE = 6 * MiB;
constexpr size_t WS_RIW = 6 * MiB + 512 * 1024;
constexpr size_t WS_TOK = 7 * MiB;
constexpr size_t WS_WIN = 17 * MiB;
constexpr size_t WS_WOUT = 21 * MiB;
constexpr size_t WS_WD = 23 * MiB;
constexpr size_t WS_A2 = 56 * MiB;
constexpr size_t WS_WGU = 136 * MiB;
constexpr size_t WS_A1 = 201 * MiB;
constexpr size_t WS_Y8 = 136 * MiB;
constexpr size_t WS_END = 264 * MiB;
constexpr size_t U_Q = 0, U_K = 16 * MiB, U_V = 20 * MiB, U_XR = 24 * MiB, U_YG = 40 * MiB;
constexpr int CW_BAR = 4096;
constexpr int CW_CNT = 16384;

constexpr int RING_BYTES = 131072;
constexpr int SCR_OFF = RING_BYTES, SCR_BYTES = 20480;
constexpr int MISC_OFF = SCR_OFF + SCR_BYTES;
constexpr int LDS_BYTES = MISC_OFF + 512;

__device__ __forceinline__ float bf2f(unsigned b) { return __uint_as_float(b << 16); }
__device__ __forceinline__ unsigned f2bf(float f) { unsigned u = __float_as_uint(f); return (u + 0x7fffu + ((u >> 16) & 1u)) >> 16; }
__device__ __forceinline__ unsigned pk2(float lo, float hi) { return f2bf(lo) | (f2bf(hi) << 16); }
__device__ __forceinline__ float fast_exp(float x) { return __builtin_amdgcn_exp2f(x * 1.44269504089f); }
__device__ __forceinline__ float sigmoidf_(float x) { return 1.0f / (1.0f + fast_exp(-x)); }

namespace pg8 {
constexpr int BM = 256, BK = 64, HALF = 128, HTB = HALF * BK * 2, STAGE_BYTES = 8 * HTB, NXCD = 8, WGM = 8;
__host__ __device__ __forceinline__ int lds_byte(int r, int c) { const int st = (r >> 4) * 2 + (c >> 5), rr = r & 15, cc = c & 31, ob = rr * 64 + cc * 2; return st * 1024 + (ob ^ (((ob >> 9) & 1) << 5)); }
__host__ __device__ __forceinline__ void stage_rc(int b, int& R, int& C) { const int st = b / 1024, sb = b % 1024, swz = sb ^ (((sb >> 9) & 1) << 5); R = (st >> 1) * 16 + swz / 64; C = (st & 1) * 32 + (swz % 64) / 2; }
__host__ __device__ __forceinline__ int perm32(int rho) { const int n = rho >> 4, i = rho & 15; return 8 * (i >> 2) + 4 * n + (i & 3); }

struct Unit { const char* B; int row0; int slot0; int pn; int e; int cnt; int y0; };

__device__ __forceinline__ unsigned cvt_pk_bf16(float lo, float hi) { unsigned r; asm volatile("v_cvt_pk_bf16_f32 %0, %1, %2" : "=v"(r) : "v"(lo), "v"(hi)); return r; }

#if GEMM_REF
template <class Epi, class Sched, bool ALIGN_EPI>
__device__ __forceinline__ void gemm_phase(LAS unsigned char* lds, const char* Abase, const int K, const Sched& S, const Epi& E) {
    const int tid = threadIdx.x, wid = __builtin_amdgcn_readfirstlane(tid >> 6), lane = tid & 63, wr = wid >> 2, wc = wid & 3, fr = lane & 15, fq = lane >> 4;
    Unit cur;
    for (int ui = 0; S.next(ui, cur); ++ui) {
        f32x4 acc[2][2][4][2];
#pragma unroll
        for (int ai = 0; ai < 2; ++ai)
#pragma unroll
            for (int bj = 0; bj < 2; ++bj)
#pragma unroll
                for (int m = 0; m < 4; ++m)
#pragma unroll
                    for (int n = 0; n < 2; ++n)
#pragma unroll
                        for (int j = 0; j < 4; ++j) {
                            const int row = ai * 128 + wr * 64 + m * 16 + fr;
                            const int col = bj * 128 + wc * 32 + (Epi::PERM ? (8 * fq + 4 * n + j) : (16 * n + 4 * fq + j));
                            const bf16* a = (const bf16*)(Abase + S.aoff(cur, row)); const bf16* b = (const bf16*)(cur.B) + (size_t)col * K;
                            float s = 0.f;
                            for (int k = 0; k < K; k += 8) { const v4u av = *(const v4u*)(a + k), bv = *(const v4u*)(b + k);
#pragma unroll
                                for (int q = 0; q < 4; ++q) { s += bf2f(av[q] & 0xffffu) * bf2f(bv[q] & 0xffffu); s += bf2f(av[q] >> 16) * bf2f(bv[q] >> 16); } }
                            acc[ai][bj][m][n][j] = s;
                        }
        E(acc, cur, wr, wc, fr, fq);
    }
    __syncthreads();
}
#else
template <class Epi, class Sched, bool ALIGN_EPI>
__device__ __forceinline__ void gemm_phase(LAS unsigned char* lds, const char* Abase, const int K_, const Sched& S, const Epi& E) {
    const int tid = threadIdx.x, wid = __builtin_amdgcn_readfirstlane(tid >> 6), lane = tid & 63, wr = wid >> 2, wc = wid & 3, fr = lane & 15, fq = lane >> 4;
    int K = K_; asm volatile("" : "+s"(K));
    const int nt = K / BK;
    int RA[2]; unsigned CA2[2], voffB[2];
#pragma unroll
    for (int i = 0; i < 2; ++i) { int R, C; stage_rc(tid * 16 + i * 8192, R, C); const int Rb = Epi::PERM ? ((R & ~31) + perm32(R & 31)) : R;
        RA[i] = R; CA2[i] = (unsigned)C * 2u; voffB[i] = (unsigned)(Rb * K + C) * 2u; }
    const size_t kstep = (size_t)(BK * 2);
    const size_t hstep = (size_t)HALF * K * 2;
    const unsigned ldsw = (unsigned)wid * 1024u;
    const int aoff = lds_byte(wr * 64 + fr, fq * 8), boff = lds_byte(wc * 32 + fr, fq * 8);
#define PG8_SA(b, h) (((b) * 2 + (h)) * HTB)
#define PG8_SB(b, h) ((4 + (b) * 2 + (h)) * HTB)
#define PG8_STAGE(bufoff, gbase, voff) do { _Pragma("unroll") for (int _i = 0; _i < 2; ++_i) \
        __builtin_amdgcn_global_load_lds((const unsigned*)((const char*)(gbase) + (voff)[_i]), (LAS unsigned*)(lds + (bufoff) + ldsw + _i * 8192), 16, 0, 0); } while (0)
#define PG8_LDA(dst, b, h) do { _Pragma("unroll") for (int m = 0; m < 4; ++m) _Pragma("unroll") for (int k = 0; k < 2; ++k) dst[m][k] = *(const LAS bf16x8*)(lds + PG8_SA(b, h) + aoff + m * 2048 + k * 1024); } while (0)
#define PG8_LDB(dst, b, h) do { _Pragma("unroll") for (int n = 0; n < 2; ++n) _Pragma("unroll") for (int k = 0; k < 2; ++k) dst[n][k] = *(const LAS bf16x8*)(lds + PG8_SB(b, h) + boff + n * 2048 + k * 1024); } while (0)
#define PG8_MMA(ai, bj, At, Bt) do { __builtin_amdgcn_s_setprio(1); _Pragma("unroll") for (int m = 0; m < 4; ++m) _Pragma("unroll") for (int n = 0; n < 2; ++n) _Pragma("unroll") for (int k = 0; k < 2; ++k) \
        acc[ai][bj][m][n] = __builtin_amdgcn_mfma_f32_16x16x32_bf16(Bt[n][k], At[m][k], acc[ai][bj][m][n], 0, 0, 0); __builtin_amdgcn_s_setprio(0); } while (0)
#define PG8_WAIT_V(n) asm volatile("s_waitcnt vmcnt(" #n ")" ::: "memory")
#define PG8_WAIT_L(n) asm volatile("s_waitcnt lgkmcnt(" #n ")" ::: "memory")
#define PG8_BAR __builtin_amdgcn_s_barrier()
#define PG8_SCHED __builtin_amdgcn_sched_barrier(0)
    Unit cur, nxt; int ui = 0;
    if (!S.next(0, cur)) return;
    unsigned curA[2][2], nxtA[2][2];
#pragma unroll
    for (int h = 0; h < 2; ++h)
#pragma unroll
        for (int i = 0; i < 2; ++i) curA[h][i] = S.aoff(cur, h * HALF + RA[i]) + CA2[i];
    f32x4 acc[2][2][4][2];
#pragma unroll
    for (int a = 0; a < 2; ++a)
#pragma unroll
        for (int b = 0; b < 2; ++b)
#pragma unroll
            for (int m = 0; m < 4; ++m)
#pragma unroll
                for (int n = 0; n < 2; ++n) acc[a][b][m][n] = (f32x4){0.f, 0.f, 0.f, 0.f};
    bf16x8 At[4][2], B0[2][2], B1[2][2];
    const char* cB = cur.B;
    PG8_STAGE(PG8_SB(0, 0), cB, voffB); PG8_STAGE(PG8_SB(0, 1), cB + hstep, voffB); PG8_STAGE(PG8_SA(0, 0), Abase, curA[0]); PG8_STAGE(PG8_SA(0, 1), Abase, curA[1]);
    if (wr == 1) PG8_BAR;
    PG8_WAIT_V(2); PG8_BAR;
    PG8_STAGE(PG8_SB(1, 0), cB + kstep, voffB); PG8_STAGE(PG8_SA(1, 0), Abase + kstep, curA[0]); PG8_STAGE(PG8_SB(1, 1), cB + hstep + kstep, voffB);
    PG8_WAIT_V(6); PG8_BAR;
    for (;;) {
        const bool has_next = S.next(ui + 1, nxt);
#pragma unroll
        for (int h = 0; h < 2; ++h)
#pragma unroll
            for (int i = 0; i < 2; ++i) nxtA[h][i] = has_next ? (S.aoff(nxt, h * HALF + RA[i]) + CA2[i]) : curA[h][i];
        const char* nB = has_next ? nxt.B : cB;
        for (int t = 0; t < nt; t += 2) {
            const bool last = (t == nt - 2);
            const char* a1 = Abase + (size_t)(t + 1) * kstep;
            const char* a2 = Abase + (last ? (size_t)0 : (size_t)(t + 2) * kstep); const char* b2 = last ? nB : cB + (size_t)(t + 2) * kstep;
            const char* a3 = a2 + kstep; const char* b3 = b2 + kstep;
            unsigned o2[2][2];
#pragma unroll
            for (int h = 0; h < 2; ++h)
#pragma unroll
                for (int i = 0; i < 2; ++i) o2[h][i] = last ? nxtA[h][i] : curA[h][i];
            PG8_LDB(B0, 0, 0); PG8_LDB(B1, 0, 1); PG8_SCHED; PG8_LDA(At, 0, 0); PG8_STAGE(PG8_SA(1, 1), a1, curA[1]);
            PG8_WAIT_V(8); PG8_WAIT_L(0); PG8_BAR; PG8_MMA(0, 0, At, B0); PG8_MMA(0, 1, At, B1); PG8_BAR; PG8_SCHED;
            PG8_LDA(At, 0, 1); PG8_STAGE(PG8_SB(0, 0), b2, voffB); PG8_STAGE(PG8_SB(0, 1), b2 + hstep, voffB); PG8_STAGE(PG8_SA(0, 0), a2, o2[0]);
            PG8_WAIT_V(8); PG8_WAIT_L(0); PG8_BAR; PG8_MMA(1, 0, At, B0); PG8_MMA(1, 1, At, B1); PG8_BAR; PG8_SCHED;
            PG8_LDB(B0, 1, 0); PG8_LDB(B1, 1, 1); PG8_SCHED; PG8_LDA(At, 1, 0); PG8_STAGE(PG8_SA(0, 1), a2, o2[1]);
            PG8_WAIT_V(8); PG8_WAIT_L(0); PG8_BAR; PG8_MMA(0, 0, At, B0); PG8_MMA(0, 1, At, B1); PG8_BAR; PG8_SCHED;
            PG8_LDA(At, 1, 1); PG8_STAGE(PG8_SB(1, 0), b3, voffB); PG8_STAGE(PG8_SB(1, 1), b3 + hstep, voffB); PG8_STAGE(PG8_SA(1, 0), a3, o2[0]);
            PG8_WAIT_V(8); PG8_WAIT_L(0); PG8_BAR; PG8_MMA(1, 0, At, B0); PG8_MMA(1, 1, At, B1); PG8_BAR; PG8_SCHED;
        }
        if constexpr (ALIGN_EPI) { if (wr == 0) PG8_BAR; }
        E(acc, cur, wr, wc, fr, fq);
        if (!has_next) break;
#pragma unroll
        for (int a = 0; a < 2; ++a)
#pragma unroll
            for (int b = 0; b < 2; ++b)
#pragma unroll
                for (int m = 0; m < 4; ++m)
#pragma unroll
                    for (int n = 0; n < 2; ++n) acc[a][b][m][n] = (f32x4){0.f, 0.f, 0.f, 0.f};
        cur = nxt; cB = nB; ++ui;
#pragma unroll
        for (int h = 0; h < 2; ++h)
#pragma unroll
            for (int i = 0; i < 2; ++i) curA[h][i] = nxtA[h][i];
        if constexpr (ALIGN_EPI) { if (wr == 1) PG8_BAR; }
    }
    PG8_WAIT_V(0);
    if constexpr (!ALIGN_EPI) { if (wr == 0) PG8_BAR; }
    PG8_BAR;
#undef PG8_SA
#undef PG8_SB
#undef PG8_STAGE
#undef PG8_LDA
#undef PG8_LDB
#undef PG8_MMA
#undef PG8_WAIT_V
#undef PG8_WAIT_L
#undef PG8_BAR
#undef PG8_SCHED
}
#endif
}

#define XB_TMO      128
#define XB_XCNT(j)  (256  + 64 * (j))
#define XB_XSUB(j)  (1280 + 64 * (j))
#define XB_XGEN(j)  (2304 + 64 * (j))
#define XB_TOP      3328
#define XB_TOPGEN   3392
#define XCD_BAR_WORDS 3456
#define XB_SPIN_CAP (1u << 18)
__device__ __forceinline__ unsigned xb_ld(unsigned* p)              { return __hip_atomic_load(p, __ATOMIC_RELAXED, __HIP_MEMORY_SCOPE_AGENT); }
__device__ __forceinline__ unsigned xb_add(unsigned* p, unsigned v) { return __hip_atomic_fetch_add(p, v, __ATOMIC_RELAXED, __HIP_MEMORY_SCOPE_AGENT); }
__device__ __forceinline__ unsigned xb_xcc_id() { return (unsigned)__builtin_amdgcn_s_getreg((3 << 11) | 20) & 0xFu; }
#define XB_SPIN(cond, bar) do { unsigned _sp = 0; while (cond) { __builtin_amdgcn_s_sleep(1); \
    if ((++_sp & 255u) == 0u) { if (xb_ld(&(bar)[XB_TMO])) break; if (_sp > XB_SPIN_CAP) { atomicAdd(&(bar)[XB_TMO], 1u); break; } } } } while (0)
struct XcdBarrier { unsigned* bar; unsigned x; volatile LAS unsigned* st; };
__device__ __forceinline__ XcdBarrier xcd_barrier_post(unsigned* bar, volatile LAS unsigned* st) {
    XcdBarrier b; b.bar = bar; b.x = xb_xcc_id(); b.st = st;
    if (threadIdx.x == 0) (void)xb_add(&bar[XB_XCNT(b.x)], 1u);
    return b;
}
__device__ __forceinline__ void xcd_barrier_complete(unsigned* bar, unsigned x, unsigned& nloc, unsigned& nx) {
    const unsigned G = gridDim.x * gridDim.y * gridDim.z;
    unsigned sum, cnt, mine, sp = 0u;
    for (;;) {
        sum = 0u; cnt = 0u; mine = 0u;
#pragma unroll
        for (unsigned j = 0; j < 16; ++j) { const unsigned c = xb_ld(&bar[XB_XCNT(j)]); sum += c; cnt += (c > 0u) ? 1u : 0u; mine = (j == x) ? c : mine; }
        if (sum == G) break;
        __builtin_amdgcn_s_sleep(1);
        if ((++sp & 255u) == 0u) { if (xb_ld(&bar[XB_TMO])) break; if (sp > XB_SPIN_CAP) { atomicAdd(&bar[XB_TMO], 1u); break; } }
    }
    nloc = mine > 0u ? mine : 1u; nx = cnt > 0u ? cnt : 1u;
}
__device__ __forceinline__ void xcd_barrier(const XcdBarrier& b) {
    asm volatile("s_waitcnt vmcnt(0)" ::: "memory");
    __syncthreads();
    if (threadIdx.x == 0) {
        unsigned* bar = b.bar;
        __builtin_amdgcn_s_waitcnt(0);
        unsigned nloc = b.st[0], nx = b.st[1];
        if (nloc == 0u) { xcd_barrier_complete(bar, b.x, nloc, nx); b.st[0] = nloc; b.st[1] = nx; }
        const unsigned old = xb_add(&bar[XB_XSUB(b.x)], 1u);
        const unsigned gen = old / nloc;
        if (old + 1u == (gen + 1u) * nloc) {
            __builtin_amdgcn_fence(__ATOMIC_RELEASE, "agent");
            asm volatile("s_waitcnt vmcnt(0)" ::: "memory");
            const unsigned og = xb_add(&bar[XB_TOP], 1u);
            const unsigned tg = og / nx;
            if (og + 1u == (tg + 1u) * nx) xb_add(&bar[XB_TOPGEN], 1u);
            else XB_SPIN(xb_ld(&bar[XB_TOPGEN]) == tg, bar);
            __builtin_amdgcn_fence(__ATOMIC_ACQUIRE, "agent");
            xb_add(&bar[XB_XGEN(b.x)], 1u);
            asm volatile("s_waitcnt vmcnt(0)" ::: "memory");
        } else {
            XB_SPIN(xb_ld(&bar[XB_XGEN(b.x)]) == gen, bar);
            __builtin_amdgcn_fence(__ATOMIC_ACQUIRE, "agent");
            asm volatile("s_waitcnt vmcnt(0)" ::: "memory");
        }
    }
    __syncthreads();
}

struct Frame {
    LAS unsigned char* lds;
    volatile LAS unsigned* MISC;
    unsigned* ctl;
    int tid, lane, wave, vcu, G;
    const float* in[25]; float* out; unsigned char* ws;
};
enum { I_X = 0, I_WIN, I_CONVW, I_CONVB, I_WRG, I_BRG, I_WIG, I_BIG, I_LAM, I_SINKS, I_GATTN, I_GLRU, I_WOUT, I_LN1G, I_LN1B, I_WROUTER, I_EBIAS, I_WGATE, I_WUP, I_WDOWN, I_WSGATE, I_WSUP, I_WSDOWN, I_LN2G, I_LN2B };

__device__ __forceinline__ float wave_sum(float v) {
#pragma unroll
    for (int o = 1; o < 64; o <<= 1) v += __shfl_xor(v, o);
    return v;
}
#define LDS_WAIT() asm volatile("s_waitcnt lgkmcnt(0)" ::: "memory")

template <class RowMap>
__device__ __forceinline__ void p0_transpose_item(const float* W, int K, int ldw, bf16* WT, const RowMap& rm, LAS float* scr, int item, int lane) {
    const int nblk = ldw / 32, kb = item / nblk, nb = item % nblk, k0 = 64 * kb, n0 = 32 * nb;
#pragma unroll 8
    for (int i = 0; i < 32; ++i) { const int kk = 2 * i + (lane >> 5); scr[kk * 33 + (lane & 31)] = W[(size_t)(k0 + kk) * ldw + n0 + (lane & 31)]; }
    LDS_WAIT(); asm volatile("" ::: "memory");
    const int c = lane & 7;
#pragma unroll
    for (int j = 0; j < 4; ++j) { const int n = (lane >> 3) + 8 * j; const LAS float* s = scr + (8 * c) * 33 + n;
        v4u o; o.x = pk2(s[0 * 33], s[1 * 33]); o.y = pk2(s[2 * 33], s[3 * 33]); o.z = pk2(s[4 * 33], s[5 * 33]); o.w = pk2(s[6 * 33], s[7 * 33]);
        *(v4u*)(WT + (size_t)rm(n0 + n) * K + k0 + 8 * c) = o; }
    LDS_WAIT(); asm volatile("" ::: "memory");
}
struct MapIn {
    __device__ __forceinline__ int operator()(int n) const {
        if (n >= AW + KVW) return n;
        const int d = n & 63, p = 32 * ((d >> 4) & 1) + 8 * ((d >> 2) & 3) + 4 * (d >> 5) + (d & 3);
        return (n & ~63) + p;
    }
};
struct MapId { int off; __device__ __forceinline__ int operator()(int n) const { return off + n; } };
struct MapDown { __device__ __forceinline__ int operator()(int n) const {
        const int lg = n & 255, wc = lg >> 6, fq = (lg >> 4) & 3, bj = (lg >> 3) & 1, nn = (lg >> 2) & 1, j = lg & 3;
        return (n & ~255) + 128 * bj + 32 * wc + 8 * fq + 4 * nn + j; } };
struct MapGU { int up; __device__ __forceinline__ int operator()(int n) const { return (n >> 7) * 256 + up * 128 + (n & 127); } };

__device__ __forceinline__ void p0_prologue(Frame& F) {
    LAS float* scr = (LAS float*)(F.lds + F.wave * 16384);
    const int gw = F.vcu * NWAVES + F.wave, NGW = F.G * NWAVES;
    { bf16* Xb = (bf16*)(F.ws + WS_A1); const float* x = F.in[I_X];
      for (int m = gw; m < S; m += NGW) { const f32x4* xr = (const f32x4*)(x + (size_t)m * D) + F.lane; v2u* o = (v2u*)(Xb + (size_t)m * D) + F.lane;
#pragma unroll
          for (int j = 0; j < 4; ++j) { const f32x4 v = xr[64 * j]; v2u w; w.x = pk2(v.x, v.y); w.y = pk2(v.z, v.w); o[64 * j] = w; } } }
    {
        constexpr int I_IN = (D / 64) * (NIN / 32), I_OUT = (D / 64) * (D / 32), I_G = (D / 64) * (DE / 32), I_DN = (DE / 64) * (D / 32);
        constexpr int PER_E = 2 * I_G + I_DN;
        constexpr int NITEMS = I_IN + I_OUT + NEX * PER_E;
        bf16* WinT = (bf16*)(F.ws + WS_WIN); bf16* WoutT = (bf16*)(F.ws + WS_WOUT); bf16* WguT = (bf16*)(F.ws + WS_WGU); bf16* WdT = (bf16*)(F.ws + WS_WD);
        for (int it = gw; it < NITEMS; it += NGW) {
            int r = it;
            if (r < I_IN) { p0_transpose_item(F.in[I_WIN], D, NIN, WinT, MapIn{}, scr, r, F.lane); continue; } r -= I_IN;
            if (r < I_OUT) { p0_transpose_item(F.in[I_WOUT], D, D, WoutT, MapId{0}, scr, r, F.lane); continue; } r -= I_OUT;
            const int e = r / PER_E; r -= e * PER_E;
            const float* wg = e < NE ? F.in[I_WGATE] + (size_t)e * D * DE : F.in[I_WSGATE];
            const float* wu = e < NE ? F.in[I_WUP] + (size_t)e * D * DE : F.in[I_WSUP];
            const float* wd = e < NE ? F.in[I_WDOWN] + (size_t)e * DE * D : F.in[I_WSDOWN];
            if (r < I_G) { p0_transpose_item(wg, D, DE, WguT + (size_t)e * 512 * D, MapGU{0}, scr, r, F.lane); continue; } r -= I_G;
            if (r < I_G) { p0_transpose_item(wu, D, DE, WguT + (size_t)e * 512 * D, MapGU{1}, scr, r, F.lane); continue; } r -= I_G;
            p0_transpose_item(wd, DE, D, WdT + (size_t)e * D * DE, MapDown{}, scr, r, F.lane);
        }
    }
    {
        const int gt = F.vcu * 512 + F.tid, NGT = F.G * 512;
        float* rc = (float*)(F.ws + WS_ROPEC); float* rs = (float*)(F.ws + WS_ROPES);
        for (int i = gt; i < S * 32; i += NGT) { const int t = i >> 5, f = i & 31;
            const double inv = exp(-(double)f * (9.210340371976184 / 32.0)); const double ang = (double)t * inv;
            rc[i] = (float)cos(ang); rs[i] = (float)sin(ang); }
        int* tok = (int*)(F.ws + WS_TOK);
        for (int i = gt; i < NEX * LCAP; i += NGT) { const bool sh = i >= NE * LCAP; tok[i] = sh ? (i - NE * LCAP) : 0; }
        if (gt == 0) F.ctl[CW_CNT + 16 * NE] = (unsigned)S;
        bf16* gw = (bf16*)(F.ws + WS_GW);
        for (int i = gt; i < 2 * 8 * 4096; i += NGT) { const int g = i >> 15, n = (i >> 12) & 7, j = (i >> 6) & 63, ii = i & 63;
            gw[i] = (bf16)f2bf((g ? F.in[I_WIG] : F.in[I_WRG])[n * 4096 + ii * 64 + j]); }
        { bf16* wrh = (bf16*)(F.ws + WS_WRH); bf16* wrl = (bf16*)(F.ws + WS_WRL); const float* wr = F.in[I_WROUTER];
          for (int i = gt; i < NE * D; i += NGT) { const int e = i >> 10, k = i & 1023; const float w = wr[(size_t)k * NE + e]; const unsigned hi = f2bf(w); wrh[i] = (bf16)hi; wrl[i] = (bf16)f2bf(w - bf2f(hi)); } }
        unsigned* ag = (unsigned*)(F.ws + WS_AGG);
        for (int i = gt; i < (256 + 16) * LW * 2 * 2; i += NGT) ag[i] = 0u;
    }
}

struct DenseOrder {
    int nM, nN, nwg, G, c, K2; const char* Bt;
    __device__ void init(int M, int N, int K, const void* Bt_, int G_, int c_) { nM = M / 256; nN = N / 256; nwg = nM * nN; G = G_; c = c_; K2 = K * 2; Bt = (const char*)Bt_; }
    __device__ __forceinline__ bool next(int i, pg8::Unit& u) const {
        const long L = (long)i * G + c; if (L >= nwg) return false;
        int wgid = (int)L; { const int q = nwg / 8, r = nwg % 8, xcd = wgid % 8, off = wgid / 8; wgid = (xcd < r ? xcd * (q + 1) : r * (q + 1) + (xcd - r) * q) + off; }
        const int nig = 8 * nN, gid = wgid / nig, fm = gid * 8, gsz = (nM - fm) < 8 ? (nM - fm) : 8;
        const int pm = fm + ((wgid % nig) % gsz), pn = (wgid % nig) / gsz;
        u.B = Bt + (size_t)pn * 256 * K2; u.row0 = pm * 256; u.slot0 = 0; u.pn = pn; u.e = 0; u.cnt = 256; u.y0 = 0; return true;
    }
    __device__ __forceinline__ unsigned aoff(const pg8::Unit& u, int r) const { return (unsigned)(u.row0 + r) * (unsigned)K2; }
};
struct MoeOrder {
    const LAS int* tb; const LAS int* cl; const LAS int* rb; const int* tok; const char* Bt; size_t bstride_e, bstride_pn; int npn, G, c, total, K2; bool gather;
    __device__ __forceinline__ bool next(int i, pg8::Unit& u) const {
        const int L = i * G + c; if (L >= total) return false;
        const int pn = L % npn, T = L / npn;
        int e = 0;
        for (int s = 32; s >= 1; s >>= 1) { const int e2 = e + s; if (e2 <= NE && __builtin_amdgcn_readfirstlane(tb[e2]) <= T) e = e2; }
        if (e + 1 <= NE && __builtin_amdgcn_readfirstlane(tb[e + 1]) <= T) e = e + 1;
        const int j = T - __builtin_amdgcn_readfirstlane(tb[e]);
        u.e = e; u.pn = pn; u.row0 = T * 256; u.slot0 = e * LCAP + j * 256; u.cnt = __builtin_amdgcn_readfirstlane(cl[e]) - j * 256; u.y0 = __builtin_amdgcn_readfirstlane(rb[e]) + j * 256;
        u.B = Bt + (size_t)e * bstride_e + (size_t)pn * bstride_pn; return true;
    }
    __device__ __forceinline__ unsigned aoff(const pg8::Unit& u, int r) const {
        if (gather) return (unsigned)tok[u.slot0 + r] * (unsigned)K2;
        return (unsigned)(u.row0 + r) * (unsigned)K2;
    }
};

struct EpiInProj {
    static constexpr bool PERM = true;
    bf16 *Q, *Kb, *V, *XR, *YG; const float *rc, *rs;
    __device__ __forceinline__ void operator()(const f32x4 (&acc)[2][2][4][2], const pg8::Unit& u, int wr, int wc, int fr, int fq) const {
        const int pn = u.pn;
#pragma unroll
        for (int ai = 0; ai < 2; ++ai)
#pragma unroll
            for (int m = 0; m < 4; ++m) {
                const size_t row = (size_t)(u.row0 + ai * 128 + wr * 64 + m * 16 + fr);
#pragma unroll
                for (int bj = 0; bj < 2; ++bj) {
                    const f32x4 v0 = acc[ai][bj][m][0], v1 = acc[ai][bj][m][1];
                    if (pn < 2 || (pn == 2 && bj == 0)) {
                        const int d0 = 16 * (wc & 1) + 4 * fq;
                        const f32x4 c = *(const f32x4*)(rc + row * 32 + d0), s = *(const f32x4*)(rs + row * 32 + d0);
                        f32x4 o1 = v0 * c - v1 * s, o2 = v1 * c + v0 * s;
                        bf16* dst;
                        if (pn < 2) { o1 = o1 * QSCALE; o2 = o2 * QSCALE; dst = Q + row * AW + pn * 256 + bj * 128 + (wc >> 1) * 64; }
                        else dst = Kb + row * KVW + (wc >> 1) * 64;
                        v2u w1, w2; w1.x = pg8::cvt_pk_bf16(o1[0], o1[1]); w1.y = pg8::cvt_pk_bf16(o1[2], o1[3]); w2.x = pg8::cvt_pk_bf16(o2[0], o2[1]); w2.y = pg8::cvt_pk_bf16(o2[2], o2[3]);
                        *(v2u*)(dst + d0) = w1; *(v2u*)(dst + 32 + d0) = w2;
                    } else {
                        bf16* dst;
                        if (pn == 2) dst = V + row * KVW + wc * 32 + 8 * fq;
                        else if (pn < 5) dst = XR + row * LW + (pn - 3) * 256 + bj * 128 + wc * 32 + 8 * fq;
                        else dst = YG + row * LW + (pn - 5) * 256 + bj * 128 + wc * 32 + 8 * fq;
                        v4u w; w.x = pg8::cvt_pk_bf16(v0[0], v0[1]); w.y = pg8::cvt_pk_bf16(v0[2], v0[3]); w.z = pg8::cvt_pk_bf16(v1[0], v1[1]); w.w = pg8::cvt_pk_bf16(v1[2], v1[3]);
                        *(v4u*)dst = w;
                    }
                }
            }
    }
};
struct EpiZ {
    static constexpr bool PERM = false;
    float* Z; const float* x;
    __device__ __forceinline__ void operator()(const f32x4 (&acc)[2][2][4][2], const pg8::Unit& u, int wr, int wc, int fr, int fq) const {
#pragma unroll
        for (int ai = 0; ai < 2; ++ai)
#pragma unroll
            for (int m = 0; m < 4; ++m) {
                const size_t off = (size_t)(u.row0 + ai * 128 + wr * 64 + m * 16 + fr) * D + u.pn * 256 + wc * 32 + 4 * fq;
#pragma unroll
                for (int bj = 0; bj < 2; ++bj)
#pragma unroll
                    for (int n = 0; n < 2; ++n) { const f32x4 xv = *(const f32x4*)(x + off + bj * 128 + n * 16); *(f32x4*)(Z + off + bj * 128 + n * 16) = acc[ai][bj][m][n] + xv * ALPHA; }
            }
    }
};
__device__ __forceinline__ float silu_mul(float g, float u) { return g * u * __builtin_amdgcn_rcpf(1.0f + fast_exp(-g)); }
struct EpiAct {
    static constexpr bool PERM = true;
    bf16* ACT;
    __device__ __forceinline__ void operator()(const f32x4 (&acc)[2][2][4][2], const pg8::Unit& u, int wr, int wc, int fr, int fq) const {
#pragma unroll
        for (int ai = 0; ai < 2; ++ai)
#pragma unroll
            for (int m = 0; m < 4; ++m) {
                const size_t row = (size_t)(u.row0 + ai * 128 + wr * 64 + m * 16 + fr);
                const f32x4 g0 = acc[ai][0][m][0], g1 = acc[ai][0][m][1], u0 = acc[ai][1][m][0], u1 = acc[ai][1][m][1];
                v4u w;
                w.x = pg8::cvt_pk_bf16(silu_mul(g0[0], u0[0]), silu_mul(g0[1], u0[1])); w.y = pg8::cvt_pk_bf16(silu_mul(g0[2], u0[2]), silu_mul(g0[3], u0[3]));
                w.z = pg8::cvt_pk_bf16(silu_mul(g1[0], u1[0]), silu_mul(g1[1], u1[1])); w.w = pg8::cvt_pk_bf16(silu_mul(g1[2], u1[2]), silu_mul(g1[3], u1[3]));
                *(v4u*)(ACT + row * DE + u.pn * 128 + wc * 32 + 8 * fq) = w;
            }
    }
};
struct EpiY8 {
    static constexpr bool PERM = true;
    unsigned char* Y; float* out;
    __device__ __forceinline__ void operator()(const f32x4 (&acc)[2][2][4][2], const pg8::Unit& u, int wr, int wc, int fr, int fq) const {
        const int colb = u.pn * 256 + 64 * wc + 16 * fq;
        if (u.e == NE) {
#pragma unroll
            for (int ai = 0; ai < 2; ++ai)
#pragma unroll
                for (int m = 0; m < 4; ++m) {
                    const int r = ai * 128 + wr * 64 + m * 16 + fr;
                    float* o = out + (size_t)((u.slot0 - NE * LCAP) + r) * D + colb;
#pragma unroll
                    for (int bj = 0; bj < 2; ++bj)
#pragma unroll
                        for (int n = 0; n < 2; ++n) { f32x4 v = *(f32x4*)(o + 8 * bj + 4 * n); v = v + acc[ai][bj][m][n]; *(f32x4*)(o + 8 * bj + 4 * n) = v; }
                    asm volatile("" ::: "memory");
                }
        } else {
#pragma unroll
            for (int ai = 0; ai < 2; ++ai)
#pragma unroll
                for (int m = 0; m < 4; ++m) {
                    const int r = ai * 128 + wr * 64 + m * 16 + fr;
                    if (r < u.cnt) {
                        v4u w;
#pragma unroll
                        for (int bj = 0; bj < 2; ++bj)
#pragma unroll
                            for (int n = 0; n < 2; ++n) { const f32x4 v = acc[ai][bj][m][n] * 64.0f; int p = 0;
                                p = __builtin_amdgcn_cvt_pk_fp8_f32(v[0], v[1], p, false); p = __builtin_amdgcn_cvt_pk_fp8_f32(v[2], v[3], p, true); w[2 * bj + n] = (unsigned)p; }
                        *(v4u*)(Y + (size_t)(u.y0 + r) * D + colb) = w;
                    }
                }
        }
    }
};

typedef float f32x16 __attribute__((ext_vector_type(16)));
constexpr int VT_STRIDE = 392;
constexpr int HROW = 1028;
__device__ __forceinline__ void attn_unit(Frame& F, int t0) {
    LAS unsigned char* Kl = F.lds; LAS unsigned char* Vt = F.lds + 49152; LAS float* red = (LAS float*)(F.lds + 49152 + 2 * 64 * VT_STRIDE);
    const bf16* Qb = (const bf16*)(F.ws + WS_A2 + U_Q); const bf16* Kb = (const bf16*)(F.ws + WS_A2 + U_K); const bf16* Vb = (const bf16*)(F.ws + WS_A2 + U_V);
    bf16* MIX = (bf16*)(F.ws + WS_A1);
    for (int p = F.tid; p < 3072; p += 512) {
        const int kv = p / 1536, r = (p % 1536) / 8, ch = p % 8, kj = t0 - 128 + r;
        v4u kval = (v4u){0u, 0u, 0u, 0u}, vval = (v4u){0u, 0u, 0u, 0u};
        if (kj >= 0) { kval = *(const v4u*)(Kb + (size_t)kj * KVW + kv * 64 + ch * 8); vval = *(const v4u*)(Vb + (size_t)kj * KVW + kv * 64 + ch * 8); }
        *(LAS v4u*)(Kl + (kv * 192 + r) * 128 + ((ch ^ (r & 7)) << 4)) = kval;
        LAS unsigned short* vcol = (LAS unsigned short*)(Vt + (kv * 64 + ch * 8) * VT_STRIDE + r * 2);
#pragma unroll
        for (int i = 0; i < 4; ++i) { vcol[(2 * i) * (VT_STRIDE / 2)] = (unsigned short)(vval[i] & 0xffffu); vcol[(2 * i + 1) * (VT_STRIDE / 2)] = (unsigned short)(vval[i] >> 16); }
    }
    __syncthreads();
    const int h = F.wave, kv = h >> 2, r = F.lane & 31, hh = F.lane >> 5;
    const float sink2 = F.in[I_SINKS][h] * LOG2E;
    f32x16 O[2][2];
    float ssq[2];
#pragma unroll
    for (int qb = 0; qb < 2; ++qb) {
        bf16x8 qf[4];
        { const bf16* qp = Qb + (size_t)(t0 + 32 * qb + r) * AW + h * 64 + 8 * hh;
#pragma unroll
          for (int ds = 0; ds < 4; ++ds) qf[ds] = *(const bf16x8*)(qp + 16 * ds); }
        f32x16 Sx[5];
#pragma unroll
        for (int i = 0; i < 5; ++i) {
            const int kt = qb + i;
#pragma unroll
            for (int e = 0; e < 16; ++e) Sx[i][e] = 0.f;
#pragma unroll
            for (int ds = 0; ds < 4; ++ds) {
                const bf16x8 a = *(const LAS bf16x8*)(Kl + (kv * 192 + 32 * kt + r) * 128 + (((2 * ds + hh) ^ (r & 7)) << 4));
                Sx[i] = __builtin_amdgcn_mfma_f32_32x32x16_bf16(a, qf[ds], Sx[i], 0, 0, 0);
            }
        }
        const int q = 32 * qb + r;
        float mx = sink2;
#pragma unroll
        for (int i = 0; i < 5; ++i)
#pragma unroll
            for (int e = 0; e < 16; ++e) {
                const int j = 32 * (qb + i) + (e & 3) + 8 * (e >> 2) + 4 * hh;
                const bool valid = (j >= q + 1) && (j <= q + 128) && (t0 - 128 + j >= 0);
                const float v = valid ? Sx[i][e] : -1e30f; Sx[i][e] = v; mx = fmaxf(mx, v);
            }
        mx = fmaxf(mx, __shfl_xor(mx, 32));
        float l = 0.f;
#pragma unroll
        for (int i = 0; i < 5; ++i)
#pragma unroll
            for (int e = 0; e < 16; ++e) { const float pv = __builtin_amdgcn_exp2f(Sx[i][e] - mx); Sx[i][e] = pv; l += pv; }
        l += __shfl_xor(l, 32);
        l += __builtin_amdgcn_exp2f(sink2 - mx);
        const float inv = 1.0f / l;
#pragma unroll
        for (int dt = 0; dt < 2; ++dt)
#pragma unroll
            for (int e = 0; e < 16; ++e) O[qb][dt][e] = 0.f;
#pragma unroll
        for (int i = 0; i < 5; ++i) {
            const int kt = qb + i;
#pragma unroll
            for (int sI = 0; sI < 2; ++sI) {
                bf16x8 pb;
                { unsigned w0 = pg8::cvt_pk_bf16(Sx[i][8 * sI + 0] * inv, Sx[i][8 * sI + 1] * inv), w1 = pg8::cvt_pk_bf16(Sx[i][8 * sI + 2] * inv, Sx[i][8 * sI + 3] * inv),
                           w2 = pg8::cvt_pk_bf16(Sx[i][8 * sI + 4] * inv, Sx[i][8 * sI + 5] * inv), w3 = pg8::cvt_pk_bf16(Sx[i][8 * sI + 6] * inv, Sx[i][8 * sI + 7] * inv);
                  v4u pw = (v4u){w0, w1, w2, w3}; pb = __builtin_bit_cast(bf16x8, pw); }
                const int key0 = 32 * kt + 16 * sI + 4 * hh;
#pragma unroll
                for (int dt = 0; dt < 2; ++dt) {
                    const LAS unsigned char* vp = Vt + (kv * 64 + 32 * dt + r) * VT_STRIDE + key0 * 2;
                    const v2u lo = *(const LAS v2u*)vp, hi = *(const LAS v2u*)(vp + 16);
                    const v4u av = (v4u){lo.x, lo.y, hi.x, hi.y};
                    O[qb][dt] = __builtin_amdgcn_mfma_f32_32x32x16_bf16(__builtin_bit_cast(bf16x8, av), pb, O[qb][dt], 0, 0, 0);
                }
            }
        }
        float sq = 0.f;
#pragma unroll
        for (int dt = 0; dt < 2; ++dt)
#pragma unroll
            for (int e = 0; e < 16; ++e) sq += O[qb][dt][e] * O[qb][dt][e];
        sq += __shfl_xor(sq, 32);
        ssq[qb] = sq;
        if (hh == 0) red[h * 64 + q] = sq;
    }
    __syncthreads();
    const float* ga = F.in[I_GATTN] + h * 64;
#pragma unroll
    for (int qb = 0; qb < 2; ++qb) {
        const int q = 32 * qb + r;
        float tot = 0.f;
#pragma unroll
        for (int w = 0; w < 8; ++w) tot += red[w * 64 + q];
        const float rsn = 1.0f / sqrtf(tot * (1.0f / AW) + NORM_EPS);
        bf16* orow = MIX + (size_t)(t0 + q) * D + h * 64;
#pragma unroll
        for (int dt = 0; dt < 2; ++dt)
#pragma unroll
            for (int g = 0; g < 4; ++g) {
                const int d = 32 * dt + 8 * g + 4 * hh;
                const f32x4 gg = *(const f32x4*)(ga + d);
                v2u w; w.x = pk2(O[qb][dt][4 * g + 0] * rsn * gg[0], O[qb][dt][4 * g + 1] * rsn * gg[1]); w.y = pk2(O[qb][dt][4 * g + 2] * rsn * gg[2], O[qb][dt][4 * g + 3] * rsn * gg[3]);
                *(v2u*)(orow + d) = w;
            }
    }
    __syncthreads();
}
__device__ __forceinline__ float neg_expm1_small(float x) { return -x * (1.f + x * 0.5f * (1.f + x * (1.f / 3.f) * (1.f + x * 0.25f * (1.f + x * 0.2f * (1.f + x * (1.f / 6.f)))))); }
__device__ __forceinline__ float gelu_tanh(float x) { const float u = 0.7978845608028654f * (x + 0.044715f * x * x * x); const float e = fast_exp(2.0f * u); return 0.5f * x * (1.0f + (1.0f - 2.0f / (e + 1.0f))); }
__device__ __forceinline__ float xor32(float x, int hh) {
    const unsigned u = __float_as_uint(x);
    const auto rr = __builtin_amdgcn_permlane32_swap(u, u, false, false);
    return __uint_as_float(hh ? rr[0] : rr[1]);
}
__device__ __forceinline__ void fold_granules(const unsigned long long* g0, size_t kstride, int k0, int k1, float& A0, float& B0, float& A1, float& B1, unsigned* tmo, int lane) {
    unsigned spins = 0; bool dead = false;
    for (int k = k0; k < k1; k += 4) {
        unsigned long long gv[4][4];
        for (;;) {
            bool ok = true;
#pragma unroll
            for (int i = 0; i < 4; ++i) { const int kk = (k + i < k1) ? k + i : k1 - 1;
                const unsigned long long* g = g0 + (size_t)kk * kstride;
                gv[i][0] = __hip_atomic_load(g, __ATOMIC_RELAXED, __HIP_MEMORY_SCOPE_AGENT); gv[i][1] = __hip_atomic_load(g + 1, __ATOMIC_RELAXED, __HIP_MEMORY_SCOPE_AGENT);
                gv[i][2] = __hip_atomic_load(g + 64, __ATOMIC_RELAXED, __HIP_MEMORY_SCOPE_AGENT); gv[i][3] = __hip_atomic_load(g + 65, __ATOMIC_RELAXED, __HIP_MEMORY_SCOPE_AGENT); }
#pragma unroll
            for (int i = 0; i < 4; ++i)
#pragma unroll
                for (int q = 0; q < 4; ++q) ok &= ((gv[i][q] >> 32) == 1ull);
            if (ok || dead) break;
            __builtin_amdgcn_s_sleep(2);
            if (++spins > (1u << 16)) { dead = true; if (lane == 0) atomicAdd(tmo, 1u); }
        }
#pragma unroll
        for (int i = 0; i < 4; ++i) if (k + i < k1) {
            const float p0 = __uint_as_float((unsigned)gv[i][0]), h0 = __uint_as_float((unsigned)gv[i][1]), p1 = __uint_as_float((unsigned)gv[i][2]), h1 = __uint_as_float((unsigned)gv[i][3]);
            A0 = p0 * A0; B0 = p0 * B0 + h0; A1 = p1 * A1; B1 = p1 * B1 + h1; }
    }
}
__device__ __forceinline__ void lru_unit(Frame& F, int chunk) {
    LAS unsigned char* xcl = F.lds;
    LAS float* ytile = (LAS float*)F.lds;
    const int t0 = chunk * 64, n = F.wave, r = F.lane & 31, hh = F.lane >> 5;
    const bf16* XR = (const bf16*)(F.ws + WS_A2 + U_XR); const bf16* YG = (const bf16*)(F.ws + WS_A2 + U_YG);
    {
        const int c = n * 64 + F.lane;
        const float* cw = F.in[I_CONVW]; const float w0 = cw[c], w1 = cw[LW + c], w2 = cw[2 * LW + c], w3 = cw[3 * LW + c], cb = F.in[I_CONVB][c];
        float x0 = t0 >= 3 ? bf2f(XR[(size_t)(t0 - 3) * LW + c]) : 0.f, x1 = t0 >= 2 ? bf2f(XR[(size_t)(t0 - 2) * LW + c]) : 0.f, x2 = t0 >= 1 ? bf2f(XR[(size_t)(t0 - 1) * LW + c]) : 0.f;
        LAS unsigned char* dst = xcl + n * 8192 + (F.lane & 7) * 2;
#pragma unroll 16
        for (int tl = 0; tl < 64; ++tl) { const float x3 = bf2f(XR[(size_t)(t0 + tl) * LW + c]);
            *(LAS unsigned short*)(dst + tl * 128 + (((F.lane >> 3) ^ (tl & 7)) << 4)) = (unsigned short)f2bf(cb + w0 * x0 + w1 * x1 + w2 * x2 + w3 * x3); x0 = x1; x1 = x2; x2 = x3; }
    }
    bf16x8 bR[2][4], bI[2][4];
    { const bf16* gw = (const bf16*)(F.ws + WS_GW);
#pragma unroll
      for (int jt = 0; jt < 2; ++jt)
#pragma unroll
          for (int ks = 0; ks < 4; ++ks) { bR[jt][ks] = *(const bf16x8*)(gw + ((0 * 8 + n) * 64 + 32 * jt + r) * 64 + 16 * ks + 8 * hh); bI[jt][ks] = *(const bf16x8*)(gw + ((1 * 8 + n) * 64 + 32 * jt + r) * 64 + 16 * ks + 8 * hh); } }
    __syncthreads();
    f32x16 aR[2][2], aI[2][2];
#pragma unroll
    for (int tt = 0; tt < 2; ++tt)
#pragma unroll
        for (int jt = 0; jt < 2; ++jt)
#pragma unroll
            for (int e = 0; e < 16; ++e) { aR[tt][jt][e] = 0.f; aI[tt][jt][e] = 0.f; }
#pragma unroll
    for (int tt = 0; tt < 2; ++tt)
#pragma unroll
        for (int ks = 0; ks < 4; ++ks) {
            const int t = 32 * tt + r;
            const bf16x8 a = *(const LAS bf16x8*)(xcl + n * 8192 + t * 128 + (((2 * ks + hh) ^ (t & 7)) << 4));
#pragma unroll
            for (int jt = 0; jt < 2; ++jt) { aR[tt][jt] = __builtin_amdgcn_mfma_f32_32x32x16_bf16(a, bR[jt][ks], aR[tt][jt], 0, 0, 0); aI[tt][jt] = __builtin_amdgcn_mfma_f32_32x32x16_bf16(a, bI[jt][ks], aI[tt][jt], 0, 0, 0); }
        }
#pragma unroll
    for (int jt = 0; jt < 2; ++jt) {
        const int cl_ = 32 * jt + r, c = n * 64 + cl_;
        const float brg = F.in[I_BRG][c], big = F.in[I_BIG][c]; const float sp8 = -8.0f * log1pf(expf(-F.in[I_LAM][c]));
#pragma unroll
        for (int tt = 0; tt < 2; ++tt)
#pragma unroll
            for (int e = 0; e < 16; ++e) {
                const int t = 32 * tt + (e & 3) + 8 * (e >> 2) + 4 * hh;
                const float xcv = bf2f(*(const LAS unsigned short*)(xcl + n * 8192 + t * 128 + (((cl_ >> 3) ^ (t & 7)) << 4) + (cl_ & 7) * 2));
                const float rg = sigmoidf_(aR[tt][jt][e] + brg), ig = sigmoidf_(aI[tt][jt][e] + big);
                const float la = rg * sp8; const float a = fast_exp(la);
                aR[tt][jt][e] = a; aI[tt][jt][e] = sqrtf(neg_expm1_small(2.0f * la)) * (ig * xcv);
            }
    }
#pragma unroll
    for (int tt = 0; tt < 2; ++tt)
#pragma unroll
        for (int jt = 0; jt < 2; ++jt)
#pragma unroll
            for (int g = 0; g < 4; ++g)
#pragma unroll
                for (int x = 1; x < 4; ++x) { aI[tt][jt][4 * g + x] = aR[tt][jt][4 * g + x] * aI[tt][jt][4 * g + x - 1] + aI[tt][jt][4 * g + x]; aR[tt][jt][4 * g + x] *= aR[tt][jt][4 * g + x - 1]; }
    float hin[2][2][4], pin[2][2][4], Hend[2], Pend[2];
#pragma unroll
    for (int jt = 0; jt < 2; ++jt) {
        float Hs = 0.f, Ps = 1.f;
#pragma unroll
        for (int tt = 0; tt < 2; ++tt)
#pragma unroll
            for (int g = 0; g < 4; ++g) {
                const float PA = aR[tt][jt][4 * g + 3], HB = aI[tt][jt][4 * g + 3];
                const float He = PA * Hs + HB, Pe = PA * Ps;
                const float Hx = xor32(He, hh), Px = xor32(Pe, hh);
                const float hi_ = hh ? Hx : Hs, pi_ = hh ? Px : Ps;
                hin[jt][tt][g] = hi_; pin[jt][tt][g] = pi_;
                const float Ho = PA * hi_ + HB, Po = PA * pi_;
                Hs = xor32(Ho, hh); Ps = xor32(Po, hh);
                if (tt == 1 && g == 3) { Hend[jt] = Ho; Pend[jt] = Po; }
            }
    }
    unsigned long long* agg = (unsigned long long*)(F.ws + WS_AGG);
    if (hh == 1) {
#pragma unroll
        for (int jt = 0; jt < 2; ++jt) { unsigned long long* g = agg + ((size_t)chunk * LW + n * 64 + 32 * jt + r) * 2;
            __hip_atomic_store(g, (1ull << 32) | (unsigned long long)__float_as_uint(Pend[jt]), __ATOMIC_RELAXED, __HIP_MEMORY_SCOPE_AGENT);
            __hip_atomic_store(g + 1, (1ull << 32) | (unsigned long long)__float_as_uint(Hend[jt]), __ATOMIC_RELAXED, __HIP_MEMORY_SCOPE_AGENT); }
    }
    __syncthreads();
    float C[2];
    {
        const unsigned long long* l1 = agg + ((size_t)n * 64 + r) * 2;
        unsigned long long* l2w = agg + (size_t)256 * LW * 2;
        const unsigned long long* l2 = l2w + ((size_t)n * 64 + r) * 2;
        const int grp = chunk >> 4, pos = chunk & 15, kb = grp * 16;
        float A0 = 1.f, B0 = 0.f, A1 = 1.f, B1 = 0.f;
        { const int mid = kb + (pos >> 1); fold_granules(l1, (size_t)LW * 2, hh ? mid : kb, hh ? chunk : mid, A0, B0, A1, B1, F.ctl + CW_TMO2, F.lane); }
        float GA0, GB0, GA1, GB1;
        { const float oa0 = xor32(A0, hh), ob0 = xor32(B0, hh), oa1 = xor32(A1, hh), ob1 = xor32(B1, hh);
          const float fa0 = hh ? oa0 : A0, fb0 = hh ? ob0 : B0, sa0 = hh ? A0 : oa0, sb0 = hh ? B0 : ob0;
          const float fa1 = hh ? oa1 : A1, fb1 = hh ? ob1 : B1, sa1 = hh ? A1 : oa1, sb1 = hh ? B1 : ob1;
          GA0 = sa0 * fa0; GB0 = sa0 * fb0 + sb0; GA1 = sa1 * fa1; GB1 = sa1 * fb1 + sb1; }
        if (pos == 15 && hh == 1) {
            unsigned long long* g = l2w + ((size_t)grp * LW + n * 64 + r) * 2;
            __hip_atomic_store(g, (1ull << 32) | (unsigned long long)__float_as_uint(Pend[0] * GA0), __ATOMIC_RELAXED, __HIP_MEMORY_SCOPE_AGENT);
            __hip_atomic_store(g + 1, (1ull << 32) | (unsigned long long)__float_as_uint(Pend[0] * GB0 + Hend[0]), __ATOMIC_RELAXED, __HIP_MEMORY_SCOPE_AGENT);
            __hip_atomic_store(g + 64, (1ull << 32) | (unsigned long long)__float_as_uint(Pend[1] * GA1), __ATOMIC_RELAXED, __HIP_MEMORY_SCOPE_AGENT);
            __hip_atomic_store(g + 65, (1ull << 32) | (unsigned long long)__float_as_uint(Pend[1] * GB1 + Hend[1]), __ATOMIC_RELAXED, __HIP_MEMORY_SCOPE_AGENT);
        }
        float LA0 = 1.f, LB0 = 0.f, LA1 = 1.f, LB1 = 0.f;
        { const int mid = grp >> 1; fold_granules(l2, (size_t)LW * 2, hh ? mid : 0, hh ? grp : mid, LA0, LB0, LA1, LB1, F.ctl + CW_TMO2, F.lane); }
        float c0, c1;
        { const float ob0 = xor32(LB0, hh), oa0 = xor32(LA0, hh), ob1 = xor32(LB1, hh), oa1 = xor32(LA1, hh);
          const float fb0 = hh ? ob0 : LB0, sa0 = hh ? LA0 : oa0, sb0 = hh ? LB0 : ob0, fb1 = hh ? ob1 : LB1, sa1 = hh ? LA1 : oa1, sb1 = hh ? LB1 : ob1;
          c0 = sa0 * fb0 + sb0; c1 = sa1 * fb1 + sb1; }
        C[0] = GA0 * c0 + GB0; C[1] = GA1 * c1 + GB1;
    }
#pragma unroll
    for (int jt = 0; jt < 2; ++jt) {
        const int c = n * 64 + 32 * jt + r;
#pragma unroll
        for (int tt = 0; tt < 2; ++tt)
#pragma unroll
            for (int g = 0; g < 4; ++g) {
                const float base = hin[jt][tt][g] + pin[jt][tt][g] * C[jt];
#pragma unroll
                for (int x = 0; x < 4; ++x) { const int e = 4 * g + x, t = 32 * tt + 8 * g + 4 * hh + x;
                    const float hv = aR[tt][jt][e] * base + aI[tt][jt][e];
                    ytile[t * 512 + c] = hv; }
            }
    }
    __syncthreads();
    {
        const float* gl = F.in[I_GLRU] + 8 * F.lane; const f32x4 g0 = *(const f32x4*)gl, g1 = *(const f32x4*)(gl + 4);
        bf16* MIX = (bf16*)(F.ws + WS_A1);
#pragma unroll
        for (int i = 0; i < 8; ++i) { const int t = 8 * F.wave + i;
            f32x4 y0 = *(const LAS f32x4*)(ytile + t * 512 + 8 * F.lane), y1 = *(const LAS f32x4*)(ytile + t * 512 + 8 * F.lane + 4);
            { const v4u yg = *(const v4u*)(YG + (size_t)(t0 + t) * LW + 8 * F.lane);
              y0[0] *= gelu_tanh(bf2f(yg[0] & 0xffffu)); y0[1] *= gelu_tanh(bf2f(yg[0] >> 16)); y0[2] *= gelu_tanh(bf2f(yg[1] & 0xffffu)); y0[3] *= gelu_tanh(bf2f(yg[1] >> 16));
              y1[0] *= gelu_tanh(bf2f(yg[2] & 0xffffu)); y1[1] *= gelu_tanh(bf2f(yg[2] >> 16)); y1[2] *= gelu_tanh(bf2f(yg[3] & 0xffffu)); y1[3] *= gelu_tanh(bf2f(yg[3] >> 16)); }
            const float sq = wave_sum((y0[0] * y0[0] + y0[1] * y0[1]) + (y0[2] * y0[2] + y0[3] * y0[3]) + (y1[0] * y1[0] + y1[1] * y1[1]) + (y1[2] * y1[2] + y1[3] * y1[3]));
            const float rsn = 1.0f / sqrtf(sq * (1.0f / LW) + NORM_EPS);
            v4u w; w.x = pk2(y0[0] * rsn * g0[0], y0[1] * rsn * g0[1]); w.y = pk2(y0[2] * rsn * g0[2], y0[3] * rsn * g0[3]); w.z = pk2(y1[0] * rsn * g1[0], y1[1] * rsn * g1[1]); w.w = pk2(y1[2] * rsn * g1[2], y1[3] * rsn * g1[3]);
            *(v4u*)(MIX + (size_t)(t0 + t) * D + AW + 8 * F.lane) = w; }
    }
    __syncthreads();
}
__device__ __forceinline__ void route_unit(Frame& F, int unit) {
    LAS float* hrow = (LAS float*)F.lds;
    LAS float* lg = (LAS float*)(F.lds + SCR_OFF + 512);
    const int t0 = unit * 32;
    const float* Z = (const float*)(F.ws + WS_A2);
    bf16* H1b = (bf16*)(F.ws + WS_A1);
    const float* g1 = F.in[I_LN1G]; const float* b1 = F.in[I_LN1B];
    {
        f32x4 v[4][4]; float mean[4], rstd[4];
#pragma unroll
        for (int rr = 0; rr < 4; ++rr) { const f32x4* zr = (const f32x4*)(Z + (size_t)(t0 + F.wave * 4 + rr) * D) + F.lane;
#pragma unroll
            for (int j = 0; j < 4; ++j) v[rr][j] = zr[64 * j]; }
#pragma unroll
        for (int rr = 0; rr < 4; ++rr) { float s = 0.f;
#pragma unroll
            for (int j = 0; j < 4; ++j) s += (v[rr][j].x + v[rr][j].y) + (v[rr][j].z + v[rr][j].w);
            mean[rr] = s; }
#pragma unroll
        for (int o = 1; o < 64; o <<= 1) {
#pragma unroll
            for (int rr = 0; rr < 4; ++rr) mean[rr] += __shfl_xor(mean[rr], o); }
#pragma unroll
        for (int rr = 0; rr < 4; ++rr) { mean[rr] *= (1.f / D); float s2 = 0.f;
#pragma unroll
            for (int j = 0; j < 4; ++j) { v[rr][j] = v[rr][j] - mean[rr]; s2 += (v[rr][j].x * v[rr][j].x + v[rr][j].y * v[rr][j].y) + (v[rr][j].z * v[rr][j].z + v[rr][j].w * v[rr][j].w); }
            rstd[rr] = s2; }
#pragma unroll
        for (int o = 1; o < 64; o <<= 1) {
#pragma unroll
            for (int rr = 0; rr < 4; ++rr) rstd[rr] += __shfl_xor(rstd[rr], o); }
#pragma unroll
        for (int j = 0; j < 4; ++j) {
            const f32x4 gg = *((const f32x4*)g1 + F.lane + 64 * j), bb = *((const f32x4*)b1 + F.lane + 64 * j);
#pragma unroll
            for (int rr = 0; rr < 4; ++rr) {
                const int tl = F.wave * 4 + rr; const size_t row = (size_t)(t0 + tl);
                const float rs = 1.f / sqrtf(rstd[rr] * (1.f / D) + NORM_EPS);
                const f32x4 hv = v[rr][j] * rs * gg + bb;
                *((LAS f32x4*)(hrow + tl * HROW) + F.lane + 64 * j) = hv;
                *((f32x4*)(F.out + row * D) + F.lane + 64 * j) = hv * ALPHA;
                v2u w; w.x = pk2(hv.x, hv.y); w.y = pk2(hv.z, hv.w); *((v2u*)(H1b + row * D) + F.lane + 64 * j) = w;
            }
        }
    }
    __syncthreads();
    {
        const int r = F.lane & 31, hh = F.lane >> 5;
        const bf16* wrh = (const bf16*)(F.ws + WS_WRH); const bf16* wrl = (const bf16*)(F.ws + WS_WRL);
        f32x16 acc[2];
#pragma unroll
        for (int e = 0; e < 16; ++e) { acc[0][e] = 0.f; acc[1][e] = 0.f; }
#pragma unroll 2
        for (int ksl = 0; ksl < 8; ++ksl) {
            const int k0 = 128 * F.wave + 16 * ksl + 8 * hh;
            const f32x4 x0 = *(const LAS f32x4*)(hrow + r * HROW + k0), x1 = *(const LAS f32x4*)(hrow + r * HROW + k0 + 4);
            v4u ah, al;
#pragma unroll
            for (int q = 0; q < 2; ++q) {
                const f32x4 xv = q ? x1 : x0;
                const unsigned h01 = pg8::cvt_pk_bf16(xv[0], xv[1]), h23 = pg8::cvt_pk_bf16(xv[2], xv[3]);
                const unsigned l01 = pg8::cvt_pk_bf16(xv[0] - bf2f(h01 & 0xffffu), xv[1] - bf2f(h01 >> 16)), l23 = pg8::cvt_pk_bf16(xv[2] - bf2f(h23 & 0xffffu), xv[3] - bf2f(h23 >> 16));
                ah[2 * q] = h01; ah[2 * q + 1] = h23; al[2 * q] = l01; al[2 * q + 1] = l23;
            }
            const bf16x8 ahi = __builtin_bit_cast(bf16x8, ah), alo = __builtin_bit_cast(bf16x8, al);
#pragma unroll
            for (int nt = 0; nt < 2; ++nt) {
                const bf16x8 bh = *(const bf16x8*)(wrh + (size_t)(32 * nt + r) * D + k0), bl = *(const bf16x8*)(wrl + (size_t)(32 * nt + r) * D + k0);
                acc[nt] = __builtin_amdgcn_mfma_f32_32x32x16_bf16(ahi, bh, acc[nt], 0, 0, 0);
                acc[nt] = __builtin_amdgcn_mfma_f32_32x32x16_bf16(ahi, bl, acc[nt], 0, 0, 0);
                acc[nt] = __builtin_amdgcn_mfma_f32_32x32x16_bf16(alo, bh, acc[nt], 0, 0, 0);
            }
        }
        __syncthreads();
        LAS float* part = hrow;
#pragma unroll
        for (int nt = 0; nt < 2; ++nt)
#pragma unroll
            for (int e = 0; e < 16; ++e) part[(F.wave * 32 + (e & 3) + 8 * (e >> 2) + 4 * hh) * 64 + 32 * nt + r] = acc[nt][e];
        __syncthreads();
#pragma unroll
        for (int i = 0; i < 4; ++i) { const int idx = F.tid + 512 * i;
            float a = 0.f;
#pragma unroll
            for (int w = 0; w < 8; ++w) a += part[w * 2048 + idx];
            lg[idx] = a; }
    }
    __syncthreads();
    {
        const int e = F.lane, grp = e >> 3;
        const float eb = F.in[I_EBIAS][e];
        int* tok = (int*)(F.ws + WS_TOK);
#pragma unroll 1
        for (int q = 0; q < 4; ++q) {
            const int tl = F.wave * 4 + q, t = t0 + tl;
            const float score = sigmoidf_(lg[tl * 64 + e]); const float sel = score + eb;
            float m1 = sel;
            m1 = fmaxf(m1, __shfl_xor(m1, 1)); m1 = fmaxf(m1, __shfl_xor(m1, 2)); m1 = fmaxf(m1, __shfl_xor(m1, 4));
            const unsigned long long bm = __ballot(sel == m1);
            const unsigned gb = (unsigned)(bm >> (8 * grp)) & 0xffu; const int first = __builtin_ctz(gb);
            float m2 = ((e & 7) == first) ? -INFINITY : sel;
            m2 = fmaxf(m2, __shfl_xor(m2, 1)); m2 = fmaxf(m2, __shfl_xor(m2, 2)); m2 = fmaxf(m2, __shfl_xor(m2, 4));
            const float gs = m1 + m2;
            int grank = 0;
#pragma unroll
            for (int g2 = 0; g2 < 8; ++g2) { const float o = __int_as_float(__builtin_amdgcn_readlane(__float_as_int(gs), 8 * g2)); grank += (o > gs || (o == gs && g2 < grp)) ? 1 : 0; }
            const float sm = grank < 4 ? sel : -INFINITY;
            int rank = 0;
#pragma unroll
            for (int e2 = 0; e2 < 64; ++e2) { const float o = __int_as_float(__builtin_amdgcn_readlane(__float_as_int(sm), e2)); rank += (o > sm || (o == sm && e2 < e)) ? 1 : 0; }
            const bool chosen = (grank < 4) && (rank < 8);
            const float wsum = wave_sum(chosen ? score : 0.f);
            if (chosen) {
                const unsigned slot = atomicAdd(F.ctl + CW_CNT + 16 * e, 1u);
                tok[e * LCAP + slot] = t;
                ((int*)(F.ws + WS_RIE))[(size_t)t * 8 + rank] = e | (int)(slot << 8);
                ((float*)(F.ws + WS_RIW))[(size_t)t * 8 + rank] = score * (2.5f / wsum);
            }
        }
    }
    __syncthreads();
}
__device__ __forceinline__ void combine_rows(Frame& F, const LAS int* rb) {
    const int gw = F.vcu * NWAVES + F.wave, NGW = F.G * NWAVES;
    const float* g2 = F.in[I_LN2G]; const float* b2 = F.in[I_LN2B];
    const unsigned char* Y = F.ws + WS_Y8; const int* rie = (const int*)(F.ws + WS_RIE); const float* riw = (const float*)(F.ws + WS_RIW);
    for (int m = gw; m < S; m += NGW) {
        f32x4* xr = (f32x4*)(F.out + (size_t)m * D) + F.lane * 4;
        f32x4 v[4];
#pragma unroll
        for (int j = 0; j < 4; ++j) v[j] = xr[j];
        const int ek = rie[(size_t)m * 8 + (F.lane & 7)]; const float wk = riw[(size_t)m * 8 + (F.lane & 7)] * (1.0f / 64.0f);
#pragma unroll
        for (int k = 0; k < 8; ++k) {
            const int ee = __builtin_amdgcn_readlane(ek, k); const float ww = __int_as_float(__builtin_amdgcn_readlane(__float_as_int(wk), k));
            const int row = rb[ee & 255] + (ee >> 8);
            const v4u y = *(const v4u*)(Y + (size_t)row * D + F.lane * 16);
#pragma unroll
            for (int j = 0; j < 4; ++j) { const f32x2 a = __builtin_amdgcn_cvt_pk_f32_fp8((int)y[j], false), b = __builtin_amdgcn_cvt_pk_f32_fp8((int)y[j], true);
                v[j].x += ww * a.x; v[j].y += ww * a.y; v[j].z += ww * b.x; v[j].w += ww * b.y; }
        }
        float s = 0.f;
#pragma unroll
        for (int j = 0; j < 4; ++j) s += (v[j].x + v[j].y) + (v[j].z + v[j].w);
        const float mean = wave_sum(s) * (1.f / D); float s2 = 0.f;
#pragma unroll
        for (int j = 0; j < 4; ++j) { v[j] = v[j] - mean; s2 += (v[j].x * v[j].x + v[j].y * v[j].y) + (v[j].z * v[j].z + v[j].w * v[j].w); }
        const float rstd = 1.f / sqrtf(wave_sum(s2) * (1.f / D) + NORM_EPS);
#pragma unroll
        for (int j = 0; j < 4; ++j) { const f32x4 gg = *((const f32x4*)g2 + F.lane * 4 + j), bb = *((const f32x4*)b2 + F.lane * 4 + j); xr[j] = v[j] * rstd * gg + bb; }
    }
}
__device__ __forceinline__ void moe_table(Frame& F, LAS int* tb, LAS int* cl, LAS int* rb) {
    if (F.tid == 0) { int acc = 0, racc = 0; for (int e = 0; e < NEX; ++e) { const int c = (int)F.ctl[CW_CNT + 16 * e]; cl[e] = c; tb[e] = acc; rb[e] = racc; acc += (c + 255) >> 8; racc += c; } tb[NEX] = acc; rb[NEX] = racc; }
    __syncthreads();
}

struct Args { const float* in[25]; float* out; unsigned char* ws; int ph_lo, ph_hi, li, pad; };
__global__ void __launch_bounds__(NWAVES * 64, 2) fwd(Args args) {
    extern __shared__ __attribute__((aligned(16))) unsigned char lds[];
    Frame F;
    F.lds = (LAS unsigned char*)lds;
    F.MISC = (volatile LAS unsigned*)(F.lds + MISC_OFF);
    F.tid = threadIdx.x; F.lane = F.tid & 63; F.wave = __builtin_amdgcn_readfirstlane(F.tid >> 6);
    F.G = gridDim.x; { const int bx = blockIdx.x; F.vcu = (F.G % 8 == 0) ? (bx % 8) * (F.G / 8) + bx / 8 : bx; }
    F.ws = args.ws; F.out = args.out; F.ctl = (unsigned*)(args.ws + WS_CTL);
#pragma unroll
    for (int i = 0; i < 25; ++i) F.in[i] = args.in[i];
    for (int u = F.tid; u < 128; u += NWAVES * 64) ((LAS unsigned*)(F.lds + MISC_OFF))[u] = 0u;
    __syncthreads();
    XcdBarrier bar; bar.bar = F.ctl + CW_BAR; bar.x = 0; bar.st = nullptr;
    if (MK_N_LAUNCHES == 1) bar = xcd_barrier_post(F.ctl + CW_BAR, F.MISC + 8);
    const int lo = args.ph_lo, hi = args.ph_hi;
#ifndef PH_MASK
#define PH_MASK 0x1ff
#endif
#define IN(k) (((PH_MASK >> (k)) & 1) && lo <= (k) && (k) < hi)
#define BOTH(k) (IN(k) && IN((k) + 1))
#ifndef PH_REP
#define PH_REP 0
#endif
#define REPS(k) for (int _rep = 0; _rep < 1 + ((PH_REP >> (k)) & 1); ++_rep)
#define GRID_BAR() do { if (MK_N_LAUNCHES == 1) xcd_barrier(bar); } while (0)

    if (IN(0)) REPS(0) { p0_prologue(F); if (BOTH(0)) GRID_BAR(); }
    if (IN(1)) REPS(1) {
        DenseOrder So; So.init(S, NIN, D, F.ws + WS_WIN, F.G, (int)blockIdx.x);
        EpiInProj E{(bf16*)(F.ws + WS_A2 + U_Q), (bf16*)(F.ws + WS_A2 + U_K), (bf16*)(F.ws + WS_A2 + U_V), (bf16*)(F.ws + WS_A2 + U_XR), (bf16*)(F.ws + WS_A2 + U_YG), (const float*)(F.ws + WS_ROPEC), (const float*)(F.ws + WS_ROPES)};
        pg8::gemm_phase<EpiInProj, DenseOrder, true>(F.lds, (const char*)(F.ws + WS_A1), D, So, E);
        if (BOTH(1)) GRID_BAR();
    }
    if (IN(2)) REPS(2) {
        { const int u = F.vcu; if (u < S / 64) { lru_unit(F, u); attn_unit(F, u * 64); } }
        if (BOTH(2)) GRID_BAR();
    }
    if (IN(4)) REPS(4) {
        DenseOrder So; So.init(S, D, D, F.ws + WS_WOUT, F.G, (int)blockIdx.x);
        EpiZ E{(float*)(F.ws + WS_A2), F.in[I_X]};
        pg8::gemm_phase<EpiZ, DenseOrder, true>(F.lds, (const char*)(F.ws + WS_A1), D, So, E);
        if (BOTH(4)) GRID_BAR();
    }
    if (IN(5)) REPS(5) {
        for (int u = F.vcu; u < S / 32; u += F.G) route_unit(F, u);
        if (BOTH(5)) GRID_BAR();
    }
    if (IN(6)) REPS(6) {
        LAS int* tb = (LAS int*)(F.lds + SCR_OFF); LAS int* cl = tb + 128; LAS int* rb = tb + 256;
        moe_table(F, tb, cl, rb);
        MoeOrder So{tb, cl, rb, (const int*)(F.ws + WS_TOK), (const char*)(F.ws + WS_WGU), (size_t)512 * D * 2, (size_t)256 * D * 2, 2, F.G, F.vcu, tb[NEX] * 2, D * 2, true};
        EpiAct E{(bf16*)(F.ws + WS_A2)};
        pg8::gemm_phase<EpiAct, MoeOrder, true>(F.lds, (const char*)(F.ws + WS_A1), D, So, E);
        if (BOTH(6)) GRID_BAR();
    }
    if (IN(7)) REPS(7) {
        LAS int* tb = (LAS int*)(F.lds + SCR_OFF); LAS int* cl = tb + 128; LAS int* rb = tb + 256;
        moe_table(F, tb, cl, rb);
        MoeOrder So{tb, cl, rb, (const int*)(F.ws + WS_TOK), (const char*)(F.ws + WS_WD), (size_t)D * DE * 2, (size_t)256 * DE * 2, 4, F.G, F.vcu, tb[NEX] * 4, DE * 2, false};
        EpiY8 E{F.ws + WS_Y8, F.out};
        pg8::gemm_phase<EpiY8, MoeOrder, true>(F.lds, (const char*)(F.ws + WS_A2), DE, So, E);
        if (BOTH(7)) GRID_BAR();
    }
    if (IN(8)) REPS(8) {
        LAS int* tb = (LAS int*)(F.lds + SCR_OFF); LAS int* cl = tb + 128; LAS int* rb = tb + 256;
        moe_table(F, tb, cl, rb);
        combine_rows(F, rb);
    }
#undef IN
#undef BOTH
#undef GRID_BAR
}

extern "C" void kernel_launch(void* const* d_in, const int* in_sizes, int n_in, void* d_out, int out_size, void* d_ws, size_t ws_size, hipStream_t stream) {
    static int grid = 0;
    if (grid == 0) {
        if (n_in != 25 || out_size != S * D || ws_size < WS_END) { fprintf(stderr, "kernel_launch: unexpected shapes (n_in %d out %d ws %zu)\n", n_in, out_size, ws_size); grid = -1; return; }
        int dev = 0, cus = 0, per_cu = 0;
        if (hipGetDevice(&dev) != hipSuccess || hipDeviceGetAttribute(&cus, hipDeviceAttributeMultiprocessorCount, dev) != hipSuccess) { grid = -1; return; }
        if (hipFuncSetAttribute((const void*)fwd, hipFuncAttributeMaxDynamicSharedMemorySize, LDS_BYTES) != hipSuccess) { fprintf(stderr, "kernel_launch: hipFuncSetAttribute failed\n"); grid = -1; return; }
        if (hipOccupancyMaxActiveBlocksPerMultiprocessor(&per_cu, (const void*)fwd, NWAVES * 64, LDS_BYTES) != hipSuccess || per_cu < 1) fprintf(stderr, "kernel_launch: occupancy query says %d\n", per_cu);
        (void)hipGetLastError();
        grid = cus;
        if (grid < S / 64) { fprintf(stderr, "kernel_launch: needs >= %d CUs (one attention/LRU unit per workgroup)\n", S / 64); grid = -1; return; }
    }
    if (grid < 0) return;
    if (hipMemsetAsync((char*)d_ws + WS_CTL, 0, CTL_ZERO_BYTES, stream) != hipSuccess) return;
    Args a{};
    for (int i = 0; i < 25; ++i) a.in[i] = (const float*)d_in[i];
    a.out = (float*)d_out; a.ws = (unsigned char*)d_ws;
    for (int li = 0; li < MK_N_LAUNCHES; ++li) {
        a.ph_lo = (MK_N_LAUNCHES == 1) ? 0 : li; a.ph_hi = (MK_N_LAUNCHES == 1) ? NPHASE : li + 1; a.li = li;
        hipLaunchKernelGGL(fwd, dim3(grid), dim3(NWAVES * 64), LDS_BYTES, stream, a);
    }
}
```

```cpp
#include <hip/hip_runtime.h>
#include <cstdio>
#include <cstdint>

#ifndef MK_N_LAUNCHES
#define MK_N_LAUNCHES 1
#endif
#ifndef PROBE_PHASE
#define PROBE_PHASE -1
#endif
#ifndef GEMM_REF
#define GEMM_REF 0
#endif

#define LAS __attribute__((address_space(3)))
#define GAS __attribute__((address_space(1)))
typedef unsigned short bf16;
typedef unsigned v4u __attribute__((ext_vector_type(4)));
typedef unsigned v2u __attribute__((ext_vector_type(2)));
typedef float f32x4 __attribute__((ext_vector_type(4)));
typedef float f32x2 __attribute__((ext_vector_type(2)));
typedef short bf16x8 __attribute__((ext_vector_type(8)));

constexpr int S = 16384, D = 1024, NIN = 1792, AW = 512, KVW = 128, LW = 512, NE = 64, NEX = 65, DE = 256, TOPK = 8;
constexpr int LCAP = 16384;
constexpr float ALPHA = 1.18920711500272f;
constexpr float NORM_EPS = 1e-5f;
constexpr float LOG2E = 1.44269504089f;
constexpr float QSCALE = 0.125f * 1.44269504089f;
constexpr int NWAVES = 8;
constexpr int NPHASE = 9;

constexpr size_t MiB = 1u << 20;
constexpr size_t WS_CTL = 0, CTL_ZERO_BYTES = 1 * MiB;
constexpr size_t WS_ROPEC = 1 * MiB, WS_ROPES = 3 * MiB;
constexpr size_t WS_AGG = 12 * MiB;
constexpr size_t WS_GW = 15 * MiB;
constexpr size_t WS_WRH = 15 * MiB + 512 * 1024, WS_WRL = 15 * MiB + 768 * 1024;
constexpr int CW_TMO2 = 8;
constexpr size_t WS_RIE = 6 * MiB;
constexpr size_t WS_RIW = 6 * MiB + 512 * 1024;
constexpr size_t WS_TOK = 7 * MiB;
constexpr size_t WS_WIN = 17 * MiB;
constexpr size_t WS_WOUT = 21 * MiB;
constexpr size_t WS_WD = 23 * MiB;
constexpr size_t WS_A2 = 56 * MiB;
constexpr size_t WS_WGU = 136 * MiB;
constexpr size_t WS_A1 = 201 * MiB;
constexpr size_t WS_Y8 = 136 * MiB;
constexpr size_t WS_END = 264 * MiB;
constexpr size_t U_Q = 0, U_K = 16 * MiB, U_V = 20 * MiB, U_XR = 24 * MiB, U_YG = 40 * MiB;
constexpr int CW_BAR = 4096;
constexpr int CW_CNT = 16384;

constexpr int RING_BYTES = 131072;
constexpr int SCR_OFF = RING_BYTES, SCR_BYTES = 20480;
constexpr int MISC_OFF = SCR_OFF + SCR_BYTES;
constexpr int LDS_BYTES = MISC_OFF + 512;

__device__ __forceinline__ float bf2f(unsigned b) { return __uint_as_float(b << 16); }
__device__ __forceinline__ unsigned f2bf(float f) { unsigned u = __float_as_uint(f); return (u + 0x7fffu + ((u >> 16) & 1u)) >> 16; }
__device__ __forceinline__ unsigned pk2(float lo, float hi) { return f2bf(lo) | (f2bf(hi) << 16); }
__device__ __forceinline__ float fast_exp(float x) { return __builtin_amdgcn_exp2f(x * 1.44269504089f); }
__device__ __forceinline__ float sigmoidf_(float x) { return __builtin_amdgcn_rcpf(1.0f + fast_exp(-x)); }

namespace pg8 {
constexpr int BM = 256, BK = 64, HALF = 128, HTB = HALF * BK * 2, STAGE_BYTES = 8 * HTB, NXCD = 8, WGM = 8;
__host__ __device__ __forceinline__ int lds_byte(int r, int c) { const int st = (r >> 4) * 2 + (c >> 5), rr = r & 15, cc = c & 31, ob = rr * 64 + cc * 2; return st * 1024 + (ob ^ (((ob >> 9) & 1) << 5)); }
__host__ __device__ __forceinline__ void stage_rc(int b, int& R, int& C) { const int st = b / 1024, sb = b % 1024, swz = sb ^ (((sb >> 9) & 1) << 5); R = (st >> 1) * 16 + swz / 64; C = (st & 1) * 32 + (swz % 64) / 2; }
__host__ __device__ __forceinline__ int perm32(int rho) { const int n = rho >> 4, i = rho & 15; return 8 * (i >> 2) + 4 * n + (i & 3); }

struct Unit { const char* B; int row0; int slot0; int pn; int e; int cnt; int y0; };

__device__ __forceinline__ unsigned cvt_pk_bf16(float lo, float hi) { unsigned r; asm volatile("v_cvt_pk_bf16_f32 %0, %1, %2" : "=v"(r) : "v"(lo), "v"(hi)); return r; }

#if GEMM_REF
template <class Epi, class Sched, bool ALIGN_EPI>
__device__ __forceinline__ void gemm_phase(LAS unsigned char* lds, const char* Abase, const int K, const Sched& S, const Epi& E) {
    const int tid = threadIdx.x, wid = __builtin_amdgcn_readfirstlane(tid >> 6), lane = tid & 63, wr = wid >> 2, wc = wid & 3, fr = lane & 15, fq = lane >> 4;
    Unit cur;
    for (int ui = 0; S.next(ui, cur); ++ui) {
        f32x4 acc[2][2][4][2];
#pragma unroll
        for (int ai = 0; ai < 2; ++ai)
#pragma unroll
            for (int bj = 0; bj < 2; ++bj)
#pragma unroll
                for (int m = 0; m < 4; ++m)
#pragma unroll
                    for (int n = 0; n < 2; ++n)
#pragma unroll
                        for (int j = 0; j < 4; ++j) {
                            const int row = ai * 128 + wr * 64 + m * 16 + fr;
                            const int col = bj * 128 + wc * 32 + (Epi::PERM ? (8 * fq + 4 * n + j) : (16 * n + 4 * fq + j));
                            const bf16* a = (const bf16*)(Abase + S.aoff(cur, row)); const bf16* b = (const bf16*)(cur.B) + (size_t)col * K;
                            float s = 0.f;
                            for (int k = 0; k < K; k += 8) { const v4u av = *(const v4u*)(a + k), bv = *(const v4u*)(b + k);
#pragma unroll
                                for (int q = 0; q < 4; ++q) { s += bf2f(av[q] & 0xffffu) * bf2f(bv[q] & 0xffffu); s += bf2f(av[q] >> 16) * bf2f(bv[q] >> 16); } }
                            acc[ai][bj][m][n][j] = s;
                        }
        E(acc, cur, wr, wc, fr, fq);
    }
    __syncthreads();
}
#else
template <class Epi, class Sched, bool ALIGN_EPI>
__device__ __forceinline__ void gemm_phase(LAS unsigned char* lds, const char* Abase, const int K_, const Sched& S, const Epi& E) {
    const int tid = threadIdx.x, wid = __builtin_amdgcn_readfirstlane(tid >> 6), lane = tid & 63, wr = wid >> 2, wc = wid & 3, fr = lane & 15, fq = lane >> 4;
    int K = K_; asm volatile("" : "+s"(K));
    const int nt = K / BK;
    int RA[2]; unsigned CA2[2], voffB[2];
#pragma unroll
    for (int i = 0; i < 2; ++i) { int R, C; stage_rc(tid * 16 + i * 8192, R, C); const int Rb = Epi::PERM ? ((R & ~31) + perm32(R & 31)) : R;
        RA[i] = R; CA2[i] = (unsigned)C * 2u; voffB[i] = (unsigned)(Rb * K + C) * 2u; }
    const size_t kstep = (size_t)(BK * 2);
    const size_t hstep = (size_t)HALF * K * 2;
    const unsigned ldsw = (unsigned)wid * 1024u;
    const int aoff = lds_byte(wr * 64 + fr, fq * 8), boff = lds_byte(wc * 32 + fr, fq * 8);
#define PG8_SA(b, h) (((b) * 2 + (h)) * HTB)
#define PG8_SB(b, h) ((4 + (b) * 2 + (h)) * HTB)
#define PG8_STAGE(bufoff, gbase, voff) do { _Pragma("unroll") for (int _i = 0; _i < 2; ++_i) \
        __builtin_amdgcn_global_load_lds((const unsigned*)((const char*)(gbase) + (voff)[_i]), (LAS unsigned*)(lds + (bufoff) + ldsw + _i * 8192), 16, 0, 0); } while (0)
#define PG8_LDA(dst, b, h) do { _Pragma("unroll") for (int m = 0; m < 4; ++m) _Pragma("unroll") for (int k = 0; k < 2; ++k) dst[m][k] = *(const LAS bf16x8*)(lds + PG8_SA(b, h) + aoff + m * 2048 + k * 1024); } while (0)
#define PG8_LDB(dst, b, h) do { _Pragma("unroll") for (int n = 0; n < 2; ++n) _Pragma("unroll") for (int k = 0; k < 2; ++k) dst[n][k] = *(const LAS bf16x8*)(lds + PG8_SB(b, h) + boff + n * 2048 + k * 1024); } while (0)
#define PG8_MMA(ai, bj, At, Bt) do { __builtin_amdgcn_s_setprio(1); _Pragma("unroll") for (int m = 0; m < 4; ++m) _Pragma("unroll") for (int n = 0; n < 2; ++n) _Pragma("unroll") for (int k = 0; k < 2; ++k) \
        acc[ai][bj][m][n] = __builtin_amdgcn_mfma_f32_16x16x32_bf16(Bt[n][k], At[m][k], acc[ai][bj][m][n], 0, 0, 0); __builtin_amdgcn_s_setprio(0); } while (0)
#define PG8_WAIT_V(n) asm volatile("s_waitcnt vmcnt(" #n ")" ::: "memory")
#define PG8_WAIT_L(n) asm volatile("s_waitcnt lgkmcnt(" #n ")" ::: "memory")
#define PG8_BAR __builtin_amdgcn_s_barrier()
#define PG8_SCHED __builtin_amdgcn_sched_barrier(0)
    Unit cur, nxt; int ui = 0;
    if (!S.next(0, cur)) return;
    unsigned curA[2][2], nxtA[2][2];
#pragma unroll
    for (int h = 0; h < 2; ++h)
#pragma unroll
        for (int i = 0; i < 2; ++i) curA[h][i] = S.aoff(cur, h * HALF + RA[i]) + CA2[i];
    f32x4 acc[2][2][4][2];
#pragma unroll
    for (int a = 0; a < 2; ++a)
#pragma unroll
        for (int b = 0; b < 2; ++b)
#pragma unroll
            for (int m = 0; m < 4; ++m)
#pragma unroll
                for (int n = 0; n < 2; ++n) acc[a][b][m][n] = (f32x4){0.f, 0.f, 0.f, 0.f};
    bf16x8 At[4][2], B0[2][2], B1[2][2];
    const char* cB = cur.B;
    PG8_STAGE(PG8_SB(0, 0), cB, voffB); PG8_STAGE(PG8_SB(0, 1), cB + hstep, voffB); PG8_STAGE(PG8_SA(0, 0), Abase, curA[0]); PG8_STAGE(PG8_SA(0, 1), Abase, curA[1]);
    if (wr == 1) PG8_BAR;
    PG8_WAIT_V(2); PG8_BAR;
    PG8_STAGE(PG8_SB(1, 0), cB + kstep, voffB); PG8_STAGE(PG8_SA(1, 0), Abase + kstep, curA[0]); PG8_STAGE(PG8_SB(1, 1), cB + hstep + kstep, voffB);
    PG8_WAIT_V(6); PG8_BAR;
    for (;;) {
        const bool has_next = S.next(ui + 1, nxt);
#pragma unroll
        for (int h = 0; h < 2; ++h)
#pragma unroll
            for (int i = 0; i < 2; ++i) nxtA[h][i] = has_next ? (S.aoff(nxt, h * HALF + RA[i]) + CA2[i]) : curA[h][i];
        const char* nB = has_next ? nxt.B : cB;
        for (int t = 0; t < nt; t += 2) {
            const bool last = (t == nt - 2);
            const char* a1 = Abase + (size_t)(t + 1) * kstep;
            const char* a2 = Abase + (last ? (size_t)0 : (size_t)(t + 2) * kstep); const char* b2 = last ? nB : cB + (size_t)(t + 2) * kstep;
            const char* a3 = a2 + kstep; const char* b3 = b2 + kstep;
            unsigned o2[2][2];
#pragma unroll
            for (int h = 0; h < 2; ++h)
#pragma unroll
                for (int i = 0; i < 2; ++i) o2[h][i] = last ? nxtA[h][i] : curA[h][i];
            PG8_LDB(B0, 0, 0); PG8_LDB(B1, 0, 1); PG8_SCHED; PG8_LDA(At, 0, 0); PG8_STAGE(PG8_SA(1, 1), a1, curA[1]);
            PG8_WAIT_V(8); PG8_WAIT_L(0); PG8_BAR; PG8_MMA(0, 0, At, B0); PG8_MMA(0, 1, At, B1); PG8_BAR; PG8_SCHED;
            PG8_LDA(At, 0, 1); PG8_STAGE(PG8_SB(0, 0), b2, voffB); PG8_STAGE(PG8_SB(0, 1), b2 + hstep, voffB); PG8_STAGE(PG8_SA(0, 0), a2, o2[0]);
            PG8_WAIT_V(8); PG8_WAIT_L(0); PG8_BAR; PG8_MMA(1, 0, At, B0); PG8_MMA(1, 1, At, B1); PG8_BAR; PG8_SCHED;
            PG8_LDB(B0, 1, 0); PG8_LDB(B1, 1, 1); PG8_SCHED; PG8_LDA(At, 1, 0); PG8_STAGE(PG8_SA(0, 1), a2, o2[1]);
            PG8_WAIT_V(8); PG8_WAIT_L(0); PG8_BAR; PG8_MMA(0, 0, At, B0); PG8_MMA(0, 1, At, B1); PG8_BAR; PG8_SCHED;
            PG8_LDA(At, 1, 1); PG8_STAGE(PG8_SB(1, 0), b3, voffB); PG8_STAGE(PG8_SB(1, 1), b3 + hstep, voffB); PG8_STAGE(PG8_SA(1, 0), a3, o2[0]);
            PG8_WAIT_V(8); PG8_WAIT_L(0); PG8_BAR; PG8_MMA(1, 0, At, B0); PG8_MMA(1, 1, At, B1); PG8_BAR; PG8_SCHED;
        }
        if constexpr (ALIGN_EPI) { if (wr == 0) PG8_BAR; }
        E(acc, cur, wr, wc, fr, fq);
        if (!has_next) break;
#pragma unroll
        for (int a = 0; a < 2; ++a)
#pragma unroll
            for (int b = 0; b < 2; ++b)
#pragma unroll
                for (int m = 0; m < 4; ++m)
#pragma unroll
                    for (int n = 0; n < 2; ++n) acc[a][b][m][n] = (f32x4){0.f, 0.f, 0.f, 0.f};
        cur = nxt; cB = nB; ++ui;
#pragma unroll
        for (int h = 0; h < 2; ++h)
#pragma unroll
            for (int i = 0; i < 2; ++i) curA[h][i] = nxtA[h][i];
        if constexpr (ALIGN_EPI) { if (wr == 1) PG8_BAR; }
    }
    PG8_WAIT_V(0);
    if constexpr (!ALIGN_EPI) { if (wr == 0) PG8_BAR; }
    PG8_BAR;
#undef PG8_SA
#undef PG8_SB
#undef PG8_STAGE
#undef PG8_LDA
#undef PG8_LDB
#undef PG8_MMA
#undef PG8_WAIT_V
#undef PG8_WAIT_L
#undef PG8_BAR
#undef PG8_SCHED
}
#endif
}

#define XB_TMO      128
#define XB_XCNT(j)  (256  + 64 * (j))
#define XB_XSUB(j)  (1280 + 64 * (j))
#define XB_XGEN(j)  (2304 + 64 * (j))
#define XB_TOP      3328
#define XB_TOPGEN   3392
#define XCD_BAR_WORDS 3456
#define XB_SPIN_CAP (1u << 18)
__device__ __forceinline__ unsigned xb_ld(unsigned* p)              { return __hip_atomic_load(p, __ATOMIC_RELAXED, __HIP_MEMORY_SCOPE_AGENT); }
__device__ __forceinline__ unsigned xb_add(unsigned* p, unsigned v) { return __hip_atomic_fetch_add(p, v, __ATOMIC_RELAXED, __HIP_MEMORY_SCOPE_AGENT); }
__device__ __forceinline__ unsigned xb_xcc_id() { return (unsigned)__builtin_amdgcn_s_getreg((3 << 11) | 20) & 0xFu; }
#define XB_SPIN(cond, bar) do { unsigned _sp = 0; while (cond) { __builtin_amdgcn_s_sleep(1); \
    if ((++_sp & 255u) == 0u) { if (xb_ld(&(bar)[XB_TMO])) break; if (_sp > XB_SPIN_CAP) { atomicAdd(&(bar)[XB_TMO], 1u); break; } } } } while (0)
struct XcdBarrier { unsigned* bar; unsigned x; volatile LAS unsigned* st; };
__device__ __forceinline__ XcdBarrier xcd_barrier_post(unsigned* bar, volatile LAS unsigned* st) {
    XcdBarrier b; b.bar = bar; b.x = xb_xcc_id(); b.st = st;
    if (threadIdx.x == 0) (void)xb_add(&bar[XB_XCNT(b.x)], 1u);
    return b;
}
__device__ __forceinline__ void xcd_barrier_complete(unsigned* bar, unsigned x, unsigned& nloc, unsigned& nx) {
    const unsigned G = gridDim.x * gridDim.y * gridDim.z;
    unsigned sum, cnt, mine, sp = 0u;
    for (;;) {
        sum = 0u; cnt = 0u; mine = 0u;
#pragma unroll
        for (unsigned j = 0; j < 16; ++j) { const unsigned c = xb_ld(&bar[XB_XCNT(j)]); sum += c; cnt += (c > 0u) ? 1u : 0u; mine = (j == x) ? c : mine; }
        if (sum == G) break;
        __builtin_amdgcn_s_sleep(1);
        if ((++sp & 255u) == 0u) { if (xb_ld(&bar[XB_TMO])) break; if (sp > XB_SPIN_CAP) { atomicAdd(&bar[XB_TMO], 1u); break; } }
    }
    nloc = mine > 0u ? mine : 1u; nx = cnt > 0u ? cnt : 1u;
}
__device__ __forceinline__ void xcd_barrier(const XcdBarrier& b) {
    asm volatile("s_waitcnt vmcnt(0)" ::: "memory");
    __syncthreads();
    if (threadIdx.x == 0) {
        unsigned* bar = b.bar;
        __builtin_amdgcn_s_waitcnt(0);
        unsigned nloc = b.st[0], nx = b.st[1];
        if (nloc == 0u) { xcd_barrier_complete(bar, b.x, nloc, nx); b.st[0] = nloc; b.st[1] = nx; }
        const unsigned old = xb_add(&bar[XB_XSUB(b.x)], 1u);
        const unsigned gen = old / nloc;
        if (old + 1u == (gen + 1u) * nloc) {
            __builtin_amdgcn_fence(__ATOMIC_RELEASE, "agent");
            asm volatile("s_waitcnt vmcnt(0)" ::: "memory");
            const unsigned og = xb_add(&bar[XB_TOP], 1u);
            const unsigned tg = og / nx;
            if (og + 1u == (tg + 1u) * nx) xb_add(&bar[XB_TOPGEN], 1u);
            else XB_SPIN(xb_ld(&bar[XB_TOPGEN]) == tg, bar);
            __builtin_amdgcn_fence(__ATOMIC_ACQUIRE, "agent");
            xb_add(&bar[XB_XGEN(b.x)], 1u);
            asm volatile("s_waitcnt vmcnt(0)" ::: "memory");
        } else {
            XB_SPIN(xb_ld(&bar[XB_XGEN(b.x)]) == gen, bar);
            __builtin_amdgcn_fence(__ATOMIC_ACQUIRE, "agent");
            asm volatile("s_waitcnt vmcnt(0)" ::: "memory");
        }
    }
    __syncthreads();
}

struct Frame {
    LAS unsigned char* lds;
    volatile LAS unsigned* MISC;
    unsigned* ctl;
    int tid, lane, wave, vcu, G;
    const float* in[25]; float* out; unsigned char* ws;
};
enum { I_X = 0, I_WIN, I_CONVW, I_CONVB, I_WRG, I_BRG, I_WIG, I_BIG, I_LAM, I_SINKS, I_GATTN, I_GLRU, I_WOUT, I_LN1G, I_LN1B, I_WROUTER, I_EBIAS, I_WGATE, I_WUP, I_WDOWN, I_WSGATE, I_WSUP, I_WSDOWN, I_LN2G, I_LN2B };

__device__ __forceinline__ float wave_sum(float v) {
#pragma unroll
    for (int o = 1; o < 64; o <<= 1) v += __shfl_xor(v, o);
    return v;
}
#define LDS_WAIT() asm volatile("s_waitcnt lgkmcnt(0)" ::: "memory")

template <class RowMap>
__device__ __forceinline__ void p0_transpose_item(const float* W, int K, int ldw, bf16* WT, const RowMap& rm, LAS float* scr, int item, int lane) {
    const int nblk = ldw / 32, kb = item / nblk, nb = item % nblk, k0 = 64 * kb, n0 = 32 * nb;
#pragma unroll 8
    for (int i = 0; i < 32; ++i) { const int kk = 2 * i + (lane >> 5); scr[kk * 33 + (lane & 31)] = W[(size_t)(k0 + kk) * ldw + n0 + (lane & 31)]; }
    LDS_WAIT(); asm volatile("" ::: "memory");
    const int c = lane & 7;
#pragma unroll
    for (int j = 0; j < 4; ++j) { const int n = (lane >> 3) + 8 * j; const LAS float* s = scr + (8 * c) * 33 + n;
        v4u o; o.x = pk2(s[0 * 33], s[1 * 33]); o.y = pk2(s[2 * 33], s[3 * 33]); o.z = pk2(s[4 * 33], s[5 * 33]); o.w = pk2(s[6 * 33], s[7 * 33]);
        *(v4u*)(WT + (size_t)rm(n0 + n) * K + k0 + 8 * c) = o; }
    LDS_WAIT(); asm volatile("" ::: "memory");
}
struct MapIn {
    __device__ __forceinline__ int operator()(int n) const {
        if (n >= AW + KVW) return n;
        const int d = n & 63, p = 32 * ((d >> 4) & 1) + 8 * ((d >> 2) & 3) + 4 * (d >> 5) + (d & 3);
        return (n & ~63) + p;
    }
};
struct MapId { int off; __device__ __forceinline__ int operator()(int n) const { return off + n; } };
struct MapDown { __device__ __forceinline__ int operator()(int n) const {
        const int lg = n & 255, wc = lg >> 6, fq = (lg >> 4) & 3, bj = (lg >> 3) & 1, nn = (lg >> 2) & 1, j = lg & 3;
        return (n & ~255) + 128 * bj + 32 * wc + 8 * fq + 4 * nn + j; } };
struct MapGU { int up; __device__ __forceinline__ int operator()(int n) const { return (n >> 7) * 256 + up * 128 + (n & 127); } };

__device__ __forceinline__ void p0_prologue(Frame& F) {
    LAS float* scr = (LAS float*)(F.lds + F.wave * 16384);
    const int gw = F.vcu * NWAVES + F.wave, NGW = F.G * NWAVES;
    { bf16* Xb = (bf16*)(F.ws + WS_A1); const float* x = F.in[I_X];
      for (int m = gw; m < S; m += NGW) { const f32x4* xr = (const f32x4*)(x + (size_t)m * D) + F.lane; v2u* o = (v2u*)(Xb + (size_t)m * D) + F.lane;
#pragma unroll
          for (int j = 0; j < 4; ++j) { const f32x4 v = xr[64 * j]; v2u w; w.x = pk2(v.x, v.y); w.y = pk2(v.z, v.w); o[64 * j] = w; } } }
    {
        constexpr int I_IN = (D / 64) * (NIN / 32), I_OUT = (D / 64) * (D / 32), I_G = (D / 64) * (DE / 32), I_DN = (DE / 64) * (D / 32);
        constexpr int PER_E = 2 * I_G + I_DN;
        constexpr int NITEMS = I_IN + I_OUT + NEX * PER_E;
        bf16* WinT = (bf16*)(F.ws + WS_WIN); bf16* WoutT = (bf16*)(F.ws + WS_WOUT); bf16* WguT = (bf16*)(F.ws + WS_WGU); bf16* WdT = (bf16*)(F.ws + WS_WD);
        for (int it = gw; it < NITEMS; it += NGW) {
            int r = it;
            if (r < I_IN) { p0_transpose_item(F.in[I_WIN], D, NIN, WinT, MapIn{}, scr, r, F.lane); continue; } r -= I_IN;
            if (r < I_OUT) { p0_transpose_item(F.in[I_WOUT], D, D, WoutT, MapId{0}, scr, r, F.lane); continue; } r -= I_OUT;
            const int e = r / PER_E; r -= e * PER_E;
            const float* wg = e < NE ? F.in[I_WGATE] + (size_t)e * D * DE : F.in[I_WSGATE];
            const float* wu = e < NE ? F.in[I_WUP] + (size_t)e * D * DE : F.in[I_WSUP];
            const float* wd = e < NE ? F.in[I_WDOWN] + (size_t)e * DE * D : F.in[I_WSDOWN];
            if (r < I_G) { p0_transpose_item(wg, D, DE, WguT + (size_t)e * 512 * D, MapGU{0}, scr, r, F.lane); continue; } r -= I_G;
            if (r < I_G) { p0_transpose_item(wu, D, DE, WguT + (size_t)e * 512 * D, MapGU{1}, scr, r, F.lane); continue; } r -= I_G;
            p0_transpose_item(wd, DE, D, WdT + (size_t)e * D * DE, MapDown{}, scr, r, F.lane);
        }
    }
    {
        const int gt = F.vcu * 512 + F.tid, NGT = F.G * 512;
        float* rc = (float*)(F.ws + WS_ROPEC); float* rs = (float*)(F.ws + WS_ROPES);
        for (int i = gt; i < (S / 64) * 32; i += NGT) { const int tb = i >> 5, f = i & 31;
            const double inv = exp(-(double)f * (9.210340371976184 / 32.0));
            double c = cos((double)(tb * 64) * inv), sn = sin((double)(tb * 64) * inv); const double cs = cos(inv), ss = sin(inv);
            for (int k = 0; k < 64; ++k) { rc[(tb * 64 + k) * 32 + f] = (float)c; rs[(tb * 64 + k) * 32 + f] = (float)sn; const double c2 = c * cs - sn * ss; sn = sn * cs + c * ss; c = c2; } }
        int* tok = (int*)(F.ws + WS_TOK);
        for (int i = gt; i < NEX * LCAP; i += NGT) { const bool sh = i >= NE * LCAP; tok[i] = sh ? (i - NE * LCAP) : 0; }
        if (gt == 0) F.ctl[CW_CNT + 16 * NE] = (unsigned)S;
        bf16* gw = (bf16*)(F.ws + WS_GW);
        for (int i = gt; i < 2 * 8 * 4096; i += NGT) { const int g = i >> 15, n = (i >> 12) & 7, j = (i >> 6) & 63, ii = i & 63;
            gw[i] = (bf16)f2bf((g ? F.in[I_WIG] : F.in[I_WRG])[n * 4096 + ii * 64 + j]); }
        { bf16* wrh = (bf16*)(F.ws + WS_WRH); bf16* wrl = (bf16*)(F.ws + WS_WRL); const float* wr = F.in[I_WROUTER];
          for (int i = gt; i < NE * D; i += NGT) { const int e = i >> 10, k = i & 1023; const float w = wr[(size_t)k * NE + e]; const unsigned hi = f2bf(w); wrh[i] = (bf16)hi; wrl[i] = (bf16)f2bf(w - bf2f(hi)); } }
        unsigned* ag = (unsigned*)(F.ws + WS_AGG);
        for (int i = gt; i < (256 + 16) * LW * 2 * 2; i += NGT) ag[i] = 0u;
    }
}

struct DenseOrder {
    int nM, nN, nwg, G, c, K2; const char* Bt;
    __device__ void init(int M, int N, int K, const void* Bt_, int G_, int c_) { nM = M / 256; nN = N / 256; nwg = nM * nN; G = G_; c = c_; K2 = K * 2; Bt = (const char*)Bt_; }
    __device__ __forceinline__ bool next(int i, pg8::Unit& u) const {
        const long L = (long)i * G + c; if (L >= nwg) return false;
        int wgid = (int)L; { const int q = nwg / 8, r = nwg % 8, xcd = wgid % 8, off = wgid / 8; wgid = (xcd < r ? xcd * (q + 1) : r * (q + 1) + (xcd - r) * q) + off; }
        const int nig = 8 * nN, gid = wgid / nig, fm = gid * 8, gsz = (nM - fm) < 8 ? (nM - fm) : 8;
        const int pm = fm + ((wgid % nig) % gsz), pn = (wgid % nig) / gsz;
        u.B = Bt + (size_t)pn * 256 * K2; u.row0 = pm * 256; u.slot0 = 0; u.pn = pn; u.e = 0; u.cnt = 256; u.y0 = 0; return true;
    }
    __device__ __forceinline__ unsigned aoff(const pg8::Unit& u, int r) const { return (unsigned)(u.row0 + r) * (unsigned)K2; }
};
struct MoeOrder {
    const LAS int* tb; const LAS int* cl; const LAS int* rb; const int* tok; const char* Bt; size_t bstride_e, bstride_pn; int npn, G, c, total, K2; bool gather;
    const LAS int* ut;
    __device__ __forceinline__ void build(LAS int* utw, int tid) const {
        if (tid < 16) {
            const int L = tid * G + c; int v0 = 0, T = 0, j = 0;
            if (L < total) {
                const int pn = L % npn; T = L / npn;
                int e = 0;
                for (int s = 32; s >= 1; s >>= 1) { const int e2 = e + s; if (e2 <= NE && tb[e2] <= T) e = e2; }
                if (e + 1 <= NE && tb[e + 1] <= T) e = e + 1;
                j = T - tb[e]; v0 = e | (pn << 8) | (1 << 16);
            }
            utw[4 * tid] = v0; utw[4 * tid + 1] = T; utw[4 * tid + 2] = j; utw[4 * tid + 3] = 0;
        }
    }
    __device__ __forceinline__ bool next(int i, pg8::Unit& u) const {
        if (i >= 16) return false;
        const int v0 = __builtin_amdgcn_readfirstlane(ut[4 * i]); if (!(v0 >> 16)) return false;
        const int T = __builtin_amdgcn_readfirstlane(ut[4 * i + 1]), j = __builtin_amdgcn_readfirstlane(ut[4 * i + 2]);
        const int e = v0 & 255, pn = (v0 >> 8) & 255;
        u.e = e; u.pn = pn; u.row0 = T * 256; u.slot0 = e * LCAP + j * 256; u.cnt = __builtin_amdgcn_readfirstlane(cl[e]) - j * 256; u.y0 = __builtin_amdgcn_readfirstlane(rb[e]) + j * 256;
        u.B = Bt + (size_t)e * bstride_e + (size_t)pn * bstride_pn; return true;
    }
    __device__ __forceinline__ unsigned aoff(const pg8::Unit& u, int r) const {
        if (gather) return (unsigned)tok[u.slot0 + r] * (unsigned)K2;
        return (unsigned)(u.row0 + r) * (unsigned)K2;
    }
};

struct EpiInProj {
    static constexpr bool PERM = true;
    bf16 *Q, *Kb, *V, *XR, *YG; const float *rc, *rs;
    __device__ __forceinline__ void operator()(const f32x4 (&acc)[2][2][4][2], const pg8::Unit& u, int wr, int wc, int fr, int fq) const {
        const int pn = u.pn;
#pragma unroll
        for (int ai = 0; ai < 2; ++ai)
#pragma unroll
            for (int m = 0; m < 4; ++m) {
                const size_t row = (size_t)(u.row0 + ai * 128 + wr * 64 + m * 16 + fr);
#pragma unroll
                for (int bj = 0; bj < 2; ++bj) {
                    const f32x4 v0 = acc[ai][bj][m][0], v1 = acc[ai][bj][m][1];
                    if (pn < 2 || (pn == 2 && bj == 0)) {
                        const int d0 = 16 * (wc & 1) + 4 * fq;
                        const f32x4 c = *(const f32x4*)(rc + row * 32 + d0), s = *(const f32x4*)(rs + row * 32 + d0);
                        f32x4 o1 = v0 * c - v1 * s, o2 = v1 * c + v0 * s;
                        bf16* dst;
                        if (pn < 2) { o1 = o1 * QSCALE; o2 = o2 * QSCALE; dst = Q + row * AW + pn * 256 + bj * 128 + (wc >> 1) * 64; }
                        else dst = Kb + row * KVW + (wc >> 1) * 64;
                        v2u w1, w2; w1.x = pg8::cvt_pk_bf16(o1[0], o1[1]); w1.y = pg8::cvt_pk_bf16(o1[2], o1[3]); w2.x = pg8::cvt_pk_bf16(o2[0], o2[1]); w2.y = pg8::cvt_pk_bf16(o2[2], o2[3]);
                        *(v2u*)(dst + d0) = w1; *(v2u*)(dst + 32 + d0) = w2;
                    } else {
                        bf16* dst;
                        if (pn == 2) dst = V + row * KVW + wc * 32 + 8 * fq;
                        else if (pn < 5) dst = XR + row * LW + (pn - 3) * 256 + bj * 128 + wc * 32 + 8 * fq;
                        else dst = YG + row * LW + (pn - 5) * 256 + bj * 128 + wc * 32 + 8 * fq;
                        v4u w; w.x = pg8::cvt_pk_bf16(v0[0], v0[1]); w.y = pg8::cvt_pk_bf16(v0[2], v0[3]); w.z = pg8::cvt_pk_bf16(v1[0], v1[1]); w.w = pg8::cvt_pk_bf16(v1[2], v1[3]);
                        *(v4u*)dst = w;
                    }
                }
            }
    }
};
struct EpiZ {
    static constexpr bool PERM = false;
    float* Z;
    __device__ __forceinline__ void operator()(const f32x4 (&acc)[2][2][4][2], const pg8::Unit& u, int wr, int wc, int fr, int fq) const {
#pragma unroll
        for (int ai = 0; ai < 2; ++ai)
#pragma unroll
            for (int m = 0; m < 4; ++m) {
                const size_t off = (size_t)(u.row0 + ai * 128 + wr * 64 + m * 16 + fr) * D + u.pn * 256 + wc * 32 + 4 * fq;
#pragma unroll
                for (int bj = 0; bj < 2; ++bj)
#pragma unroll
                    for (int n = 0; n < 2; ++n) *(f32x4*)(Z + off + bj * 128 + n * 16) = acc[ai][bj][m][n];
            }
    }
};
__device__ __forceinline__ float silu_mul(float g, float u) { return g * u * __builtin_amdgcn_rcpf(1.0f + fast_exp(-g)); }
struct EpiAct {
    static constexpr bool PERM = true;
    bf16* ACT;
    __device__ __forceinline__ void operator()(const f32x4 (&acc)[2][2][4][2], const pg8::Unit& u, int wr, int wc, int fr, int fq) const {
#pragma unroll
        for (int ai = 0; ai < 2; ++ai)
#pragma unroll
            for (int m = 0; m < 4; ++m) {
                const size_t row = (size_t)(u.row0 + ai * 128 + wr * 64 + m * 16 + fr);
                const f32x4 g0 = acc[ai][0][m][0], g1 = acc[ai][0][m][1], u0 = acc[ai][1][m][0], u1 = acc[ai][1][m][1];
                v4u w;
                w.x = pg8::cvt_pk_bf16(silu_mul(g0[0], u0[0]), silu_mul(g0[1], u0[1])); w.y = pg8::cvt_pk_bf16(silu_mul(g0[2], u0[2]), silu_mul(g0[3], u0[3]));
                w.z = pg8::cvt_pk_bf16(silu_mul(g1[0], u1[0]), silu_mul(g1[1], u1[1])); w.w = pg8::cvt_pk_bf16(silu_mul(g1[2], u1[2]), silu_mul(g1[3], u1[3]));
                *(v4u*)(ACT + row * DE + u.pn * 128 + wc * 32 + 8 * fq) = w;
            }
    }
};
struct EpiY8 {
    static constexpr bool PERM = true;
    unsigned char* Y; float* out; int probe;
    __device__ __forceinline__ void operator()(const f32x4 (&acc)[2][2][4][2], const pg8::Unit& u, int wr, int wc, int fr, int fq) const {
        const int colb = u.pn * 256 + 64 * wc + 16 * fq;
        if (u.e == NE) {
            if (probe) return;
#pragma unroll
            for (int ai = 0; ai < 2; ++ai)
#pragma unroll
                for (int m = 0; m < 4; ++m) {
                    const int r = ai * 128 + wr * 64 + m * 16 + fr;
                    float* o = out + (size_t)((u.slot0 - NE * LCAP) + r) * D + colb;
#pragma unroll
                    for (int bj = 0; bj < 2; ++bj)
#pragma unroll
                        for (int n = 0; n < 2; ++n) { f32x4 v = *(f32x4*)(o + 8 * bj + 4 * n); v = v + acc[ai][bj][m][n]; *(f32x4*)(o + 8 * bj + 4 * n) = v; }
                    asm volatile("" ::: "memory");
                }
        } else {
#pragma unroll
            for (int ai = 0; ai < 2; ++ai)
#pragma unroll
                for (int m = 0; m < 4; ++m) {
                    const int r = ai * 128 + wr * 64 + m * 16 + fr;
                    if (r < u.cnt) {
                        v4u w;
#pragma unroll
                        for (int bj = 0; bj < 2; ++bj)
#pragma unroll
                            for (int n = 0; n < 2; ++n) { const f32x4 v = acc[ai][bj][m][n] * 64.0f; int p = 0;
                                p = __builtin_amdgcn_cvt_pk_fp8_f32(v[0], v[1], p, false); p = __builtin_amdgcn_cvt_pk_fp8_f32(v[2], v[3], p, true); w[2 * bj + n] = (unsigned)p; }
                        *(v4u*)(Y + (size_t)(u.y0 + r) * D + colb) = w;
                    }
                }
        }
    }
};

typedef float f32x16 __attribute__((ext_vector_type(16)));
constexpr int VT_STRIDE = 392;
constexpr int HROW = 1028;
__device__ __forceinline__ void attn_unit(Frame& F, int t0) {
    LAS unsigned char* Kl = F.lds; LAS unsigned char* Vt = F.lds + 49152; LAS float* red = (LAS float*)(F.lds + 49152 + 2 * 64 * VT_STRIDE);
    const bf16* Qb = (const bf16*)(F.ws + WS_A2 + U_Q); const bf16* Kb = (const bf16*)(F.ws + WS_A2 + U_K); const bf16* Vb = (const bf16*)(F.ws + WS_A2 + U_V);
    bf16* MIX = (bf16*)(F.ws + WS_A1);
    bf16x8 qf[2][4]; f32x4 gav[2][4];
    { const int h = F.wave, r = F.lane & 31, hh = F.lane >> 5;
#pragma unroll
      for (int qb = 0; qb < 2; ++qb) { const bf16* qp = Qb + (size_t)(t0 + 32 * qb + r) * AW + h * 64 + 8 * hh;
#pragma unroll
          for (int ds = 0; ds < 4; ++ds) qf[qb][ds] = *(const bf16x8*)(qp + 16 * ds); }
#pragma unroll
      for (int dt = 0; dt < 2; ++dt)
#pragma unroll
          for (int g = 0; g < 4; ++g) gav[dt][g] = *(const f32x4*)(F.in[I_GATTN] + h * 64 + 32 * dt + 8 * g + 4 * hh); }
    const float sink2 = F.in[I_SINKS][F.wave] * LOG2E;
    for (int p = F.tid; p < 3072; p += 512) {
        const int kv = p / 1536, r = (p % 1536) / 8, ch = p % 8, kj = t0 - 128 + r;
        v4u kval = (v4u){0u, 0u, 0u, 0u}, vval = (v4u){0u, 0u, 0u, 0u};
        if (kj >= 0) { kval = *(const v4u*)(Kb + (size_t)kj * KVW + kv * 64 + ch * 8); vval = *(const v4u*)(Vb + (size_t)kj * KVW + kv * 64 + ch * 8); }
        *(LAS v4u*)(Kl + (kv * 192 + r) * 128 + ((ch ^ (r & 7)) << 4)) = kval;
        LAS unsigned short* vcol = (LAS unsigned short*)(Vt + (kv * 64 + ch * 8) * VT_STRIDE + r * 2);
#pragma unroll
        for (int i = 0; i < 4; ++i) { vcol[(2 * i) * (VT_STRIDE / 2)] = (unsigned short)(vval[i] & 0xffffu); vcol[(2 * i + 1) * (VT_STRIDE / 2)] = (unsigned short)(vval[i] >> 16); }
    }
    __syncthreads();
    const int h = F.wave, kv = h >> 2, r = F.lane & 31, hh = F.lane >> 5;
    f32x16 O[2][2];
    float ssq[2];
#pragma unroll
    for (int qb = 0; qb < 2; ++qb) {
        f32x16 Sx[5];
#pragma unroll
        for (int i = 0; i < 5; ++i) {
            const int kt = qb + i;
#pragma unroll
            for (int e = 0; e < 16; ++e) Sx[i][e] = 0.f;
#pragma unroll
            for (int ds = 0; ds < 4; ++ds) {
                const bf16x8 a = *(const LAS bf16x8*)(Kl + (kv * 192 + 32 * kt + r) * 128 + (((2 * ds + hh) ^ (r & 7)) << 4));
                Sx[i] = __builtin_amdgcn_mfma_f32_32x32x16_bf16(a, qf[qb][ds], Sx[i], 0, 0, 0);
            }
        }
        const int q = 32 * qb + r;
        float mx = sink2;
#pragma unroll
        for (int i = 0; i < 5; ++i)
#pragma unroll
            for (int e = 0; e < 16; ++e) {
                const int j = 32 * (qb + i) + (e & 3) + 8 * (e >> 2) + 4 * hh;
                const bool valid = (j >= q + 1) && (j <= q + 128) && (t0 - 128 + j >= 0);
                const float v = valid ? Sx[i][e] : -1e30f; Sx[i][e] = v; mx = fmaxf(mx, v);
            }
        mx = fmaxf(mx, __shfl_xor(mx, 32));
        float l = 0.f;
#pragma unroll
        for (int i = 0; i < 5; ++i)
#pragma unroll
            for (int e = 0; e < 16; ++e) { const float pv = __builtin_amdgcn_exp2f(Sx[i][e] - mx); Sx[i][e] = pv; l += pv; }
        l += __shfl_xor(l, 32);
        l += __builtin_amdgcn_exp2f(sink2 - mx);
        const float inv = __builtin_amdgcn_rcpf(l);
#pragma unroll
        for (int dt = 0; dt < 2; ++dt)
#pragma unroll
            for (int e = 0; e < 16; ++e) O[qb][dt][e] = 0.f;
#pragma unroll
        for (int i = 0; i < 5; ++i) {
            const int kt = qb + i;
#pragma unroll
            for (int sI = 0; sI < 2; ++sI) {
                bf16x8 pb;
                { unsigned w0 = pg8::cvt_pk_bf16(Sx[i][8 * sI + 0] * inv, Sx[i][8 * sI + 1] * inv), w1 = pg8::cvt_pk_bf16(Sx[i][8 * sI + 2] * inv, Sx[i][8 * sI + 3] * inv),
                           w2 = pg8::cvt_pk_bf16(Sx[i][8 * sI + 4] * inv, Sx[i][8 * sI + 5] * inv), w3 = pg8::cvt_pk_bf16(Sx[i][8 * sI + 6] * inv, Sx[i][8 * sI + 7] * inv);
                  v4u pw = (v4u){w0, w1, w2, w3}; pb = __builtin_bit_cast(bf16x8, pw); }
                const int key0 = 32 * kt + 16 * sI + 4 * hh;
#pragma unroll
                for (int dt = 0; dt < 2; ++dt) {
                    const LAS unsigned char* vp = Vt + (kv * 64 + 32 * dt + r) * VT_STRIDE + key0 * 2;
                    const v2u lo = *(const LAS v2u*)vp, hi = *(const LAS v2u*)(vp + 16);
                    const v4u av = (v4u){lo.x, lo.y, hi.x, hi.y};
                    O[qb][dt] = __builtin_amdgcn_mfma_f32_32x32x16_bf16(__builtin_bit_cast(bf16x8, av), pb, O[qb][dt], 0, 0, 0);
                }
            }
        }
        float sq = 0.f;
#pragma unroll
        for (int dt = 0; dt < 2; ++dt)
#pragma unroll
            for (int e = 0; e < 16; ++e) sq += O[qb][dt][e] * O[qb][dt][e];
        sq += __shfl_xor(sq, 32);
        ssq[qb] = sq;
        if (hh == 0) red[h * 64 + q] = sq;
    }
    __syncthreads();
#pragma unroll
    for (int qb = 0; qb < 2; ++qb) {
        const int q = 32 * qb + r;
        float tot = 0.f;
#pragma unroll
        for (int w = 0; w < 8; ++w) tot += red[w * 64 + q];
        const float rsn = 1.0f / sqrtf(tot * (1.0f / AW) + NORM_EPS);
        bf16* orow = MIX + (size_t)(t0 + q) * D + h * 64;
#pragma unroll
        for (int dt = 0; dt < 2; ++dt)
#pragma unroll
            for (int g = 0; g < 4; ++g) {
                const int d = 32 * dt + 8 * g + 4 * hh;
                const f32x4 gg = gav[dt][g];
                v2u w; w.x = pk2(O[qb][dt][4 * g + 0] * rsn * gg[0], O[qb][dt][4 * g + 1] * rsn * gg[1]); w.y = pk2(O[qb][dt][4 * g + 2] * rsn * gg[2], O[qb][dt][4 * g + 3] * rsn * gg[3]);
                *(v2u*)(orow + d) = w;
            }
    }
    __syncthreads();
}
__device__ __forceinline__ float neg_expm1_small(float x) { return -x * (1.f + x * 0.5f * (1.f + x * (1.f / 3.f) * (1.f + x * 0.25f * (1.f + x * 0.2f * (1.f + x * (1.f / 6.f)))))); }
__device__ __forceinline__ float gelu_tanh(float x) { const float u = 0.7978845608028654f * (x + 0.044715f * x * x * x); const float e = fast_exp(2.0f * u); return x * (1.0f - __builtin_amdgcn_rcpf(e + 1.0f)); }
__device__ __forceinline__ float xor32(float x, int hh) {
    const unsigned u = __float_as_uint(x);
    const auto rr = __builtin_amdgcn_permlane32_swap(u, u, false, false);
    return __uint_as_float(hh ? rr[0] : rr[1]);
}
__device__ __forceinline__ void fold_granules(const unsigned long long* g0, size_t kstride, int k0, int k1, float& A0, float& B0, float& A1, float& B1, unsigned* tmo, int lane) {
    unsigned spins = 0; bool dead = false;
    for (int k = k0; k < k1; k += 4) {
        unsigned long long gv[4][4];
        for (;;) {
            bool ok = true;
#pragma unroll
            for (int i = 0; i < 4; ++i) { const int kk = (k + i < k1) ? k + i : k1 - 1;
                const unsigned long long* g = g0 + (size_t)kk * kstride;
                gv[i][0] = __hip_atomic_load(g, __ATOMIC_RELAXED, __HIP_MEMORY_SCOPE_AGENT); gv[i][1] = __hip_atomic_load(g + 1, __ATOMIC_RELAXED, __HIP_MEMORY_SCOPE_AGENT);
                gv[i][2] = __hip_atomic_load(g + 64, __ATOMIC_RELAXED, __HIP_MEMORY_SCOPE_AGENT); gv[i][3] = __hip_atomic_load(g + 65, __ATOMIC_RELAXED, __HIP_MEMORY_SCOPE_AGENT); }
#pragma unroll
            for (int i = 0; i < 4; ++i)
#pragma unroll
                for (int q = 0; q < 4; ++q) ok &= ((gv[i][q] >> 32) == 1ull);
            if (ok || dead) break;
            __builtin_amdgcn_s_sleep(2);
            if (++spins > (1u << 16)) { dead = true; if (lane == 0) atomicAdd(tmo, 1u); }
        }
#pragma unroll
        for (int i = 0; i < 4; ++i) if (k + i < k1) {
            const float p0 = __uint_as_float((unsigned)gv[i][0]), h0 = __uint_as_float((unsigned)gv[i][1]), p1 = __uint_as_float((unsigned)gv[i][2]), h1 = __uint_as_float((unsigned)gv[i][3]);
            A0 = p0 * A0; B0 = p0 * B0 + h0; A1 = p1 * A1; B1 = p1 * B1 + h1; }
    }
}
__device__ __forceinline__ void lru_unit(Frame& F, int chunk) {
    LAS unsigned char* xcl = F.lds;
    LAS float* ytile = (LAS float*)F.lds;
    const int t0 = chunk * 64, n = F.wave, r = F.lane & 31, hh = F.lane >> 5;
    const bf16* XR = (const bf16*)(F.ws + WS_A2 + U_XR); const bf16* YG = (const bf16*)(F.ws + WS_A2 + U_YG);
    bf16x8 bR[2][4], bI[2][4];
    { const bf16* gw = (const bf16*)(F.ws + WS_GW);
#pragma unroll
      for (int jt = 0; jt < 2; ++jt)
#pragma unroll
          for (int ks = 0; ks < 4; ++ks) { bR[jt][ks] = *(const bf16x8*)(gw + ((0 * 8 + n) * 64 + 32 * jt + r) * 64 + 16 * ks + 8 * hh); bI[jt][ks] = *(const bf16x8*)(gw + ((1 * 8 + n) * 64 + 32 * jt + r) * 64 + 16 * ks + 8 * hh); } }
    float brg_[2], big_[2], lam_[2];
#pragma unroll
    for (int jt = 0; jt < 2; ++jt) { const int c = n * 64 + 32 * jt + r; brg_[jt] = F.in[I_BRG][c]; big_[jt] = F.in[I_BIG][c]; lam_[jt] = F.in[I_LAM][c]; }
    {
        const int c = n * 64 + F.lane;
        const float* cw = F.in[I_CONVW]; const float w0 = cw[c], w1 = cw[LW + c], w2 = cw[2 * LW + c], w3 = cw[3 * LW + c], cb = F.in[I_CONVB][c];
        LAS unsigned char* raw = F.lds + 65536;
        for (int p = F.tid; p < 67 * 64; p += 512) { const int row = p >> 6, ch = p & 63, tr = t0 - 3 + row;
            v4u val = (v4u){0u, 0u, 0u, 0u};
            if (tr >= 0) val = *(const v4u*)(XR + (size_t)tr * LW + ch * 8);
            *(LAS v4u*)(raw + row * 1024 + ch * 16) = val; }
        __syncthreads();
        const LAS unsigned short* rc_ = (const LAS unsigned short*)raw + c;
        float x0 = bf2f(rc_[0]), x1 = bf2f(rc_[512]), x2 = bf2f(rc_[1024]);
        LAS unsigned char* dst = xcl + n * 8192 + (F.lane & 7) * 2;
#pragma unroll 16
        for (int tl = 0; tl < 64; ++tl) { const float x3 = bf2f(rc_[(tl + 3) * 512]);
            *(LAS unsigned short*)(dst + tl * 128 + (((F.lane >> 3) ^ (tl & 7)) << 4)) = (unsigned short)f2bf(cb + w0 * x0 + w1 * x1 + w2 * x2 + w3 * x3); x0 = x1; x1 = x2; x2 = x3; }
    }
    __syncthreads();
    f32x16 aR[2][2], aI[2][2];
#pragma unroll
    for (int tt = 0; tt < 2; ++tt)
#pragma unroll
        for (int jt = 0; jt < 2; ++jt)
#pragma unroll
            for (int e = 0; e < 16; ++e) { aR[tt][jt][e] = 0.f; aI[tt][jt][e] = 0.f; }
#pragma unroll
    for (int tt = 0; tt < 2; ++tt)
#pragma unroll
        for (int ks = 0; ks < 4; ++ks) {
            const int t = 32 * tt + r;
            const bf16x8 a = *(const LAS bf16x8*)(xcl + n * 8192 + t * 128 + (((2 * ks + hh) ^ (t & 7)) << 4));
#pragma unroll
            for (int jt = 0; jt < 2; ++jt) { aR[tt][jt] = __builtin_amdgcn_mfma_f32_32x32x16_bf16(a, bR[jt][ks], aR[tt][jt], 0, 0, 0); aI[tt][jt] = __builtin_amdgcn_mfma_f32_32x32x16_bf16(a, bI[jt][ks], aI[tt][jt], 0, 0, 0); }
        }
#pragma unroll
    for (int jt = 0; jt < 2; ++jt) {
        const int cl_ = 32 * jt + r;
        const float brg = brg_[jt], big = big_[jt]; const float sp8 = -8.0f * log1pf(expf(-lam_[jt]));
#pragma unroll
        for (int tt = 0; tt < 2; ++tt)
#pragma unroll
            for (int e = 0; e < 16; ++e) {
                const int t = 32 * tt + (e & 3) + 8 * (e >> 2) + 4 * hh;
                const float xcv = bf2f(*(const LAS unsigned short*)(xcl + n * 8192 + t * 128 + (((cl_ >> 3) ^ (t & 7)) << 4) + (cl_ & 7) * 2));
                const float rg = sigmoidf_(aR[tt][jt][e] + brg), ig = sigmoidf_(aI[tt][jt][e] + big);
                const float la = rg * sp8; const float a = fast_exp(la);
                aR[tt][jt][e] = a; aI[tt][jt][e] = __builtin_amdgcn_sqrtf(neg_expm1_small(2.0f * la)) * (ig * xcv);
            }
    }
#pragma unroll
    for (int tt = 0; tt < 2; ++tt)
#pragma unroll
        for (int jt = 0; jt < 2; ++jt)
#pragma unroll
            for (int g = 0; g < 4; ++g)
#pragma unroll
                for (int x = 1; x < 4; ++x) { aI[tt][jt][4 * g + x] = aR[tt][jt][4 * g + x] * aI[tt][jt][4 * g + x - 1] + aI[tt][jt][4 * g + x]; aR[tt][jt][4 * g + x] *= aR[tt][jt][4 * g + x - 1]; }
    float hin[2][2][4], pin[2][2][4], Hend[2], Pend[2];
#pragma unroll
    for (int jt = 0; jt < 2; ++jt) {
        float Hs = 0.f, Ps = 1.f;
#pragma unroll
        for (int tt = 0; tt < 2; ++tt)
#pragma unroll
            for (int g = 0; g < 4; ++g) {
                const float PA = aR[tt][jt][4 * g + 3], HB = aI[tt][jt][4 * g + 3];
                const float He = PA * Hs + HB, Pe = PA * Ps;
                const float Hx = xor32(He, hh), Px = xor32(Pe, hh);
                const float hi_ = hh ? Hx : Hs, pi_ = hh ? Px : Ps;
                hin[jt][tt][g] = hi_; pin[jt][tt][g] = pi_;
                const float Ho = PA * hi_ + HB, Po = PA * pi_;
                Hs = xor32(Ho, hh); Ps = xor32(Po, hh);
                if (tt == 1 && g == 3) { Hend[jt] = Ho; Pend[jt] = Po; }
            }
    }
    unsigned long long* agg = (unsigned long long*)(F.ws + WS_AGG);
    if (hh == 1) {
#pragma unroll
        for (int jt = 0; jt < 2; ++jt) { unsigned long long* g = agg + ((size_t)chunk * LW + n * 64 + 32 * jt + r) * 2;
            __hip_atomic_store(g, (1ull << 32) | (unsigned long long)__float_as_uint(Pend[jt]), __ATOMIC_RELAXED, __HIP_MEMORY_SCOPE_AGENT);
            __hip_atomic_store(g + 1, (1ull << 32) | (unsigned long long)__float_as_uint(Hend[jt]), __ATOMIC_RELAXED, __HIP_MEMORY_SCOPE_AGENT); }
    }
    __syncthreads();
    float C[2];
    {
        const unsigned long long* l1 = agg + ((size_t)n * 64 + r) * 2;
        unsigned long long* l2w = agg + (size_t)256 * LW * 2;
        const unsigned long long* l2 = l2w + ((size_t)n * 64 + r) * 2;
        const int grp = chunk >> 4, pos = chunk & 15, kb = grp * 16;
        float A0 = 1.f, B0 = 0.f, A1 = 1.f, B1 = 0.f;
        { const int mid = kb + (pos >> 1); fold_granules(l1, (size_t)LW * 2, hh ? mid : kb, hh ? chunk : mid, A0, B0, A1, B1, F.ctl + CW_TMO2, F.lane); }
        float GA0, GB0, GA1, GB1;
        { const float oa0 = xor32(A0, hh), ob0 = xor32(B0, hh), oa1 = xor32(A1, hh), ob1 = xor32(B1, hh);
          const float fa0 = hh ? oa0 : A0, fb0 = hh ? ob0 : B0, sa0 = hh ? A0 : oa0, sb0 = hh ? B0 : ob0;
          const float fa1 = hh ? oa1 : A1, fb1 = hh ? ob1 : B1, sa1 = hh ? A1 : oa1, sb1 = hh ? B1 : ob1;
          GA0 = sa0 * fa0; GB0 = sa0 * fb0 + sb0; GA1 = sa1 * fa1; GB1 = sa1 * fb1 + sb1; }
        if (pos == 15 && hh == 1) {
            unsigned long long* g = l2w + ((size_t)grp * LW + n * 64 + r) * 2;
            __hip_atomic_store(g, (1ull << 32) | (unsigned long long)__float_as_uint(Pend[0] * GA0), __ATOMIC_RELAXED, __HIP_MEMORY_SCOPE_AGENT);
            __hip_atomic_store(g + 1, (1ull << 32) | (unsigned long long)__float_as_uint(Pend[0] * GB0 + Hend[0]), __ATOMIC_RELAXED, __HIP_MEMORY_SCOPE_AGENT);
            __hip_atomic_store(g + 64, (1ull << 32) | (unsigned long long)__float_as_uint(Pend[1] * GA1), __ATOMIC_RELAXED, __HIP_MEMORY_SCOPE_AGENT);
            __hip_atomic_store(g + 65, (1ull << 32) | (unsigned long long)__float_as_uint(Pend[1] * GB1 + Hend[1]), __ATOMIC_RELAXED, __HIP_MEMORY_SCOPE_AGENT);
        }
        float LA0 = 1.f, LB0 = 0.f, LA1 = 1.f, LB1 = 0.f;
        { const int mid = grp >> 1; fold_granules(l2, (size_t)LW * 2, hh ? mid : 0, hh ? grp : mid, LA0, LB0, LA1, LB1, F.ctl + CW_TMO2, F.lane); }
        float c0, c1;
        { const float ob0 = xor32(LB0, hh), oa0 = xor32(LA0, hh), ob1 = xor32(LB1, hh), oa1 = xor32(LA1, hh);
          const float fb0 = hh ? ob0 : LB0, sa0 = hh ? LA0 : oa0, sb0 = hh ? LB0 : ob0, fb1 = hh ? ob1 : LB1, sa1 = hh ? LA1 : oa1, sb1 = hh ? LB1 : ob1;
          c0 = sa0 * fb0 + sb0; c1 = sa1 * fb1 + sb1; }
        C[0] = GA0 * c0 + GB0; C[1] = GA1 * c1 + GB1;
    }
#pragma unroll
    for (int jt = 0; jt < 2; ++jt) {
        const int c = n * 64 + 32 * jt + r;
#pragma unroll
        for (int tt = 0; tt < 2; ++tt)
#pragma unroll
            for (int g = 0; g < 4; ++g) {
                const float base = hin[jt][tt][g] + pin[jt][tt][g] * C[jt];
#pragma unroll
                for (int x = 0; x < 4; ++x) { const int e = 4 * g + x, t = 32 * tt + 8 * g + 4 * hh + x;
                    const float hv = aR[tt][jt][e] * base + aI[tt][jt][e];
                    ytile[t * 512 + c] = hv; }
            }
    }
    v4u ygv[8];
#pragma unroll
    for (int i = 0; i < 8; ++i) ygv[i] = *(const v4u*)(YG + (size_t)(t0 + 8 * F.wave + i) * LW + 8 * F.lane);
    __syncthreads();
    {
        const float* gl = F.in[I_GLRU] + 8 * F.lane; const f32x4 g0 = *(const f32x4*)gl, g1 = *(const f32x4*)(gl + 4);
        bf16* MIX = (bf16*)(F.ws + WS_A1);
#pragma unroll
        for (int i = 0; i < 8; ++i) { const int t = 8 * F.wave + i;
            f32x4 y0 = *(const LAS f32x4*)(ytile + t * 512 + 8 * F.lane), y1 = *(const LAS f32x4*)(ytile + t * 512 + 8 * F.lane + 4);
            { const v4u yg = ygv[i];
              y0[0] *= gelu_tanh(bf2f(yg[0] & 0xffffu)); y0[1] *= gelu_tanh(bf2f(yg[0] >> 16)); y0[2] *= gelu_tanh(bf2f(yg[1] & 0xffffu)); y0[3] *= gelu_tanh(bf2f(yg[1] >> 16));
              y1[0] *= gelu_tanh(bf2f(yg[2] & 0xffffu)); y1[1] *= gelu_tanh(bf2f(yg[2] >> 16)); y1[2] *= gelu_tanh(bf2f(yg[3] & 0xffffu)); y1[3] *= gelu_tanh(bf2f(yg[3] >> 16)); }
            const float sq = wave_sum((y0[0] * y0[0] + y0[1] * y0[1]) + (y0[2] * y0[2] + y0[3] * y0[3]) + (y1[0] * y1[0] + y1[1] * y1[1]) + (y1[2] * y1[2] + y1[3] * y1[3]));
            const float rsn = 1.0f / sqrtf(sq * (1.0f / LW) + NORM_EPS);
            v4u w; w.x = pk2(y0[0] * rsn * g0[0], y0[1] * rsn * g0[1]); w.y = pk2(y0[2] * rsn * g0[2], y0[3] * rsn * g0[3]); w.z = pk2(y1[0] * rsn * g1[0], y1[1] * rsn * g1[1]); w.w = pk2(y1[2] * rsn * g1[2], y1[3] * rsn * g1[3]);
            *(v4u*)(MIX + (size_t)(t0 + t) * D + AW + 8 * F.lane) = w; }
    }
    __syncthreads();
}
struct RtSel { bool chosen[4]; int rank[4]; float wgt[4]; unsigned li[4]; };
__device__ __forceinline__ void rt_load(Frame& F, int unit, f32x4 (&v)[4][4]) {
    const float* Z = (const float*)(F.ws + WS_A2); const float* X = F.in[I_X];
#pragma unroll
    for (int rr = 0; rr < 4; ++rr) { const f32x4* zr = (const f32x4*)(Z + (size_t)(unit * 32 + F.wave * 4 + rr) * D) + F.lane;
#pragma unroll
        for (int j = 0; j < 4; ++j) v[rr][j] = zr[64 * j]; }
#pragma unroll
    for (int rr = 0; rr < 4; ++rr) { const f32x4* xr = (const f32x4*)(X + (size_t)(unit * 32 + F.wave * 4 + rr) * D) + F.lane;
#pragma unroll
        for (int j = 0; j < 4; ++j) v[rr][j] = v[rr][j] + xr[64 * j] * ALPHA; }
}
__device__ __forceinline__ void rt_norm(Frame& F, int unit, f32x4 (&v)[4][4], LAS float* hrow) {
    bf16* H1b = (bf16*)(F.ws + WS_A1);
    const float* g1 = F.in[I_LN1G]; const float* b1 = F.in[I_LN1B];
    float mean[4], rstd[4];
#pragma unroll
    for (int rr = 0; rr < 4; ++rr) { float s = 0.f;
#pragma unroll
        for (int j = 0; j < 4; ++j) s += (v[rr][j].x + v[rr][j].y) + (v[rr][j].z + v[rr][j].w);
        mean[rr] = s; }
#pragma unroll
    for (int o = 1; o < 64; o <<= 1) {
#pragma unroll
        for (int rr = 0; rr < 4; ++rr) mean[rr] += __shfl_xor(mean[rr], o); }
#pragma unroll
    for (int rr = 0; rr < 4; ++rr) { mean[rr] *= (1.f / D); float s2 = 0.f;
#pragma unroll
        for (int j = 0; j < 4; ++j) { v[rr][j] = v[rr][j] - mean[rr]; s2 += (v[rr][j].x * v[rr][j].x + v[rr][j].y * v[rr][j].y) + (v[rr][j].z * v[rr][j].z + v[rr][j].w * v[rr][j].w); }
        rstd[rr] = s2; }
#pragma unroll
    for (int o = 1; o < 64; o <<= 1) {
#pragma unroll
        for (int rr = 0; rr < 4; ++rr) rstd[rr] += __shfl_xor(rstd[rr], o); }
#pragma unroll
    for (int j = 0; j < 4; ++j) {
        const f32x4 gg = *((const f32x4*)g1 + F.lane + 64 * j), bb = *((const f32x4*)b1 + F.lane + 64 * j);
#pragma unroll
        for (int rr = 0; rr < 4; ++rr) {
            const int tl = F.wave * 4 + rr; const size_t row = (size_t)(unit * 32 + tl);
            const float rs = 1.f / sqrtf(rstd[rr] * (1.f / D) + NORM_EPS);
            const f32x4 hv = v[rr][j] * rs * gg + bb;
            *((LAS f32x4*)(hrow + tl * HROW) + F.lane + 64 * j) = hv;
            *((f32x4*)(F.out + row * D) + F.lane + 64 * j) = hv * ALPHA;
            v2u w; w.x = pk2(hv.x, hv.y); w.y = pk2(hv.z, hv.w); *((v2u*)(H1b + row * D) + F.lane + 64 * j) = w;
        }
    }
}
__device__ __forceinline__ void rt_logits(Frame& F, LAS float* hrow, LAS float* lg) {
    const int r = F.lane & 31, hh = F.lane >> 5;
    const bf16* wrh = (const bf16*)(F.ws + WS_WRH); const bf16* wrl = (const bf16*)(F.ws + WS_WRL);
    f32x16 acc[2];
#pragma unroll
    for (int e = 0; e < 16; ++e) { acc[0][e] = 0.f; acc[1][e] = 0.f; }
#pragma unroll 4
    for (int ksl = 0; ksl < 8; ++ksl) {
        const int k0 = 128 * F.wave + 16 * ksl + 8 * hh;
        const f32x4 x0 = *(const LAS f32x4*)(hrow + r * HROW + k0), x1 = *(const LAS f32x4*)(hrow + r * HROW + k0 + 4);
        v4u ah, al;
#pragma unroll
        for (int q = 0; q < 2; ++q) {
            const f32x4 xv = q ? x1 : x0;
            const unsigned h01 = pg8::cvt_pk_bf16(xv[0], xv[1]), h23 = pg8::cvt_pk_bf16(xv[2], xv[3]);
            const unsigned l01 = pg8::cvt_pk_bf16(xv[0] - bf2f(h01 & 0xffffu), xv[1] - bf2f(h01 >> 16)), l23 = pg8::cvt_pk_bf16(xv[2] - bf2f(h23 & 0xffffu), xv[3] - bf2f(h23 >> 16));
            ah[2 * q] = h01; ah[2 * q + 1] = h23; al[2 * q] = l01; al[2 * q + 1] = l23;
        }
        const bf16x8 ahi = __builtin_bit_cast(bf16x8, ah), alo = __builtin_bit_cast(bf16x8, al);
#pragma unroll
        for (int nt = 0; nt < 2; ++nt) {
            const bf16x8 bh = *(const bf16x8*)(wrh + (size_t)(32 * nt + r) * D + k0), bl = *(const bf16x8*)(wrl + (size_t)(32 * nt + r) * D + k0);
            acc[nt] = __builtin_amdgcn_mfma_f32_32x32x16_bf16(ahi, bh, acc[nt], 0, 0, 0);
            acc[nt] = __builtin_amdgcn_mfma_f32_32x32x16_bf16(ahi, bl, acc[nt], 0, 0, 0);
            acc[nt] = __builtin_amdgcn_mfma_f32_32x32x16_bf16(alo, bh, acc[nt], 0, 0, 0);
        }
    }
    __syncthreads();
    LAS float* part = hrow;
#pragma unroll
    for (int nt = 0; nt < 2; ++nt)
#pragma unroll
        for (int e = 0; e < 16; ++e) part[(F.wave * 32 + (e & 3) + 8 * (e >> 2) + 4 * hh) * 64 + 32 * nt + r] = acc[nt][e];
    __syncthreads();
#pragma unroll
    for (int i = 0; i < 4; ++i) { const int idx = F.tid + 512 * i;
        float a = 0.f;
#pragma unroll
        for (int w = 0; w < 8; ++w) a += part[w * 2048 + idx];
        lg[idx] = a; }
    __syncthreads();
}
__device__ __forceinline__ void rt_topk(Frame& F, const LAS float* lg, LAS unsigned* lc, RtSel& R) {
    const int e = F.lane, grp = e >> 3;
    const float eb = F.in[I_EBIAS][e];
#pragma unroll
    for (int q = 0; q < 4; ++q) {
        const int tl = F.wave * 4 + q;
        const float score = sigmoidf_(lg[tl * 64 + e]); const float sel = score + eb;
        float m1 = sel;
        m1 = fmaxf(m1, __shfl_xor(m1, 1)); m1 = fmaxf(m1, __shfl_xor(m1, 2)); m1 = fmaxf(m1, __shfl_xor(m1, 4));
        const unsigned long long bm = __ballot(sel == m1);
        const unsigned gb = (unsigned)(bm >> (8 * grp)) & 0xffu; const int first = __builtin_ctz(gb | 0x100u);
        float m2 = ((e & 7) == first) ? -INFINITY : sel;
        m2 = fmaxf(m2, __shfl_xor(m2, 1)); m2 = fmaxf(m2, __shfl_xor(m2, 2)); m2 = fmaxf(m2, __shfl_xor(m2, 4));
        const float gs = m1 + m2;
        int grank = 0;
#pragma unroll
        for (int g2 = 0; g2 < 8; ++g2) { const float o = __int_as_float(__builtin_amdgcn_readlane(__float_as_int(gs), 8 * g2)); grank += (o > gs || (o == gs && g2 < grp)) ? 1 : 0; }
        const float sm = grank < 4 ? sel : -INFINITY;
        int rank = 0;
#pragma unroll
        for (int e2 = 0; e2 < 64; ++e2) { const float o = __int_as_float(__builtin_amdgcn_readlane(__float_as_int(sm), e2)); rank += (o > sm || (o == sm && e2 < e)) ? 1 : 0; }
        const bool chosen = (grank < 4) && (rank < 8);
        const float wsum = wave_sum(chosen ? score : 0.f);
        R.chosen[q] = chosen; R.rank[q] = rank; R.wgt[q] = score * (2.5f / wsum);
        R.li[q] = chosen ? __hip_atomic_fetch_add(lc + e, 1u, __ATOMIC_RELAXED, __HIP_MEMORY_SCOPE_WORKGROUP) : 0u;
    }
}
__device__ __forceinline__ void rt_emit(Frame& F, int unit, const LAS unsigned* gb, const RtSel& R) {
    int* tok = (int*)(F.ws + WS_TOK); const int e = F.lane;
    const unsigned base = gb[e];
#pragma unroll
    for (int q = 0; q < 4; ++q) if (R.chosen[q]) { const int t = unit * 32 + F.wave * 4 + q; const unsigned slot = base + R.li[q];
        tok[e * LCAP + slot] = t;
        ((int*)(F.ws + WS_RIE))[(size_t)t * 8 + R.rank[q]] = e | (int)(slot << 8);
        ((float*)(F.ws + WS_RIW))[(size_t)t * 8 + R.rank[q]] = R.wgt[q]; }
}
__device__ __forceinline__ void route_phase(Frame& F) {
    LAS float* hrow = (LAS float*)F.lds;
    LAS float* lg = (LAS float*)(F.lds + SCR_OFF + 512);
    LAS unsigned* lc = (LAS unsigned*)(F.lds + SCR_OFF + 512 + 8192);
    LAS unsigned* gb = lc + 64;
    const int u0 = F.vcu, u1 = F.vcu + F.G;
    const bool has0 = u0 < S / 32, has1 = u1 < S / 32;
    if (!has0) return;
    if (F.tid < 64) lc[F.tid] = 0u;
    f32x4 v[4][4];
    RtSel R0, R1;
    rt_load(F, u0, v);
    rt_norm(F, u0, v, hrow);
    if (has1) rt_load(F, u1, v);
    __syncthreads();
    rt_logits(F, hrow, lg);
    rt_topk(F, lg, lc, R0);
    if (has1) {
        __syncthreads();
        rt_norm(F, u1, v, hrow);
        __syncthreads();
        rt_logits(F, hrow, lg);
        rt_topk(F, lg, lc, R1);
    }
    __syncthreads();
    if (F.tid < 64) { const unsigned c = lc[F.tid]; gb[F.tid] = c ? atomicAdd(F.ctl + CW_CNT + 16 * F.tid, c) : 0u; }
    __syncthreads();
    rt_emit(F, u0, gb, R0);
    if (has1) rt_emit(F, u1, gb, R1);
}
struct CombRow { v4u y[8]; float w[8]; };
__device__ __forceinline__ void comb_load(Frame& F, const LAS int* rb, int ek, float wk, CombRow& R) {
    const unsigned char* Y = F.ws + WS_Y8;
#pragma unroll
    for (int k = 0; k < 8; ++k) {
        const int ee = __builtin_amdgcn_readlane(ek, k); R.w[k] = __int_as_float(__builtin_amdgcn_readlane(__float_as_int(wk), k));
        const int row = rb[ee & 255] + (ee >> 8);
        R.y[k] = *(const v4u*)(Y + (size_t)row * D + F.lane * 16);
    }
}
__device__ __forceinline__ void comb_finish(Frame& F, int m, CombRow& R) {
    f32x4* xo = (f32x4*)(F.out + (size_t)m * D) + F.lane * 4;
    f32x4 v[4], a4[4];
#pragma unroll
    for (int j = 0; j < 4; ++j) { v[j] = xo[j]; a4[j] = (f32x4){0.f, 0.f, 0.f, 0.f}; }
#pragma unroll
    for (int k = 0; k < 8; ++k) { const float ww = R.w[k];
#pragma unroll
        for (int j = 0; j < 4; ++j) { const f32x2 a = __builtin_amdgcn_cvt_pk_f32_fp8((int)R.y[k][j], false), b = __builtin_amdgcn_cvt_pk_f32_fp8((int)R.y[k][j], true);
            a4[j].x += ww * a.x; a4[j].y += ww * a.y; a4[j].z += ww * b.x; a4[j].w += ww * b.y; } }
    float s = 0.f;
#pragma unroll
    for (int j = 0; j < 4; ++j) { v[j] = v[j] + a4[j]; s += (v[j].x + v[j].y) + (v[j].z + v[j].w); }
    const float mean = wave_sum(s) * (1.f / D); float s2 = 0.f;
#pragma unroll
    for (int j = 0; j < 4; ++j) { v[j] = v[j] - mean; s2 += (v[j].x * v[j].x + v[j].y * v[j].y) + (v[j].z * v[j].z + v[j].w * v[j].w); }
    const float rstd = 1.f / sqrtf(wave_sum(s2) * (1.f / D) + NORM_EPS);
#pragma unroll
    for (int j = 0; j < 4; ++j) { const f32x4 gg = *((const f32x4*)F.in[I_LN2G] + F.lane * 4 + j), bb = *((const f32x4*)F.in[I_LN2B] + F.lane * 4 + j); xo[j] = v[j] * rstd * gg + bb; }
}
__device__ __forceinline__ void combine_rows(Frame& F, const LAS int* rb) {
    const int gw = F.vcu * NWAVES + F.wave, NGW = F.G * NWAVES;
    const int* rie = (const int*)(F.ws + WS_RIE); const float* riw = (const float*)(F.ws + WS_RIW);
    const int nrows = (S - gw + NGW - 1) / NGW;
    if (nrows <= 0) return;
    const int l8 = F.lane & 7;
    int ek1 = rie[(size_t)gw * 8 + l8]; float wk1 = riw[(size_t)gw * 8 + l8] * (1.0f / 64.0f);
    int ek2 = 0; float wk2 = 0.f;
    if (nrows > 1) { ek2 = rie[(size_t)(gw + NGW) * 8 + l8]; wk2 = riw[(size_t)(gw + NGW) * 8 + l8] * (1.0f / 64.0f); }
    CombRow RA, RB;
    comb_load(F, rb, ek1, wk1, RA);
#pragma unroll 1
    for (int i = 0; i < nrows; i += 2) {
        int ek3 = 0; float wk3 = 0.f;
        if (i + 2 < nrows) { const size_t m = (size_t)(gw + (i + 2) * NGW); ek3 = rie[m * 8 + l8]; wk3 = riw[m * 8 + l8] * (1.0f / 64.0f); }
        if (i + 1 < nrows) comb_load(F, rb, ek2, wk2, RB);
        comb_finish(F, gw + i * NGW, RA);
        int ek4 = 0; float wk4 = 0.f;
        if (i + 3 < nrows) { const size_t m = (size_t)(gw + (i + 3) * NGW); ek4 = rie[m * 8 + l8]; wk4 = riw[m * 8 + l8] * (1.0f / 64.0f); }
        if (i + 2 < nrows) comb_load(F, rb, ek3, wk3, RA);
        if (i + 1 < nrows) comb_finish(F, gw + (i + 1) * NGW, RB);
        ek2 = ek4; wk2 = wk4;
    }
}
__device__ __forceinline__ void moe_table(Frame& F, LAS int* tb, LAS int* cl, LAS int* rb) {
    if (F.tid == 0) { int acc = 0, racc = 0; for (int e = 0; e < NEX; ++e) { const int c = (int)F.ctl[CW_CNT + 16 * e]; cl[e] = c; tb[e] = acc; rb[e] = racc; acc += (c + 255) >> 8; racc += c; } tb[NEX] = acc; rb[NEX] = racc; }
    __syncthreads();
}

struct Args { const float* in[25]; float* out; unsigned char* ws; int ph_lo, ph_hi, li, pad; };
__global__ void __launch_bounds__(NWAVES * 64, 2) fwd(Args args) {
    extern __shared__ __attribute__((aligned(16))) unsigned char lds[];
    Frame F;
    F.lds = (LAS unsigned char*)lds;
    F.MISC = (volatile LAS unsigned*)(F.lds + MISC_OFF);
    F.tid = threadIdx.x; F.lane = F.tid & 63; F.wave = __builtin_amdgcn_readfirstlane(F.tid >> 6);
    F.G = gridDim.x; { const int bx = blockIdx.x; F.vcu = (F.G % 8 == 0) ? (bx % 8) * (F.G / 8) + bx / 8 : bx; }
    F.ws = args.ws; F.out = args.out; F.ctl = (unsigned*)(args.ws + WS_CTL);
#pragma unroll
    for (int i = 0; i < 25; ++i) F.in[i] = args.in[i];
    for (int u = F.tid; u < 128; u += NWAVES * 64) ((LAS unsigned*)(F.lds + MISC_OFF))[u] = 0u;
    __syncthreads();
    XcdBarrier bar; bar.bar = F.ctl + CW_BAR; bar.x = 0; bar.st = nullptr;
    if (MK_N_LAUNCHES == 1) bar = xcd_barrier_post(F.ctl + CW_BAR, F.MISC + 8);
    const int lo = args.ph_lo, hi = args.ph_hi;
#ifndef PH_MASK
#define PH_MASK 0x1ff
#endif
#define IN(k) (((PH_MASK >> (k)) & 1) && lo <= (k) && (k) < hi)
#define BOTH(k) (IN(k) && IN((k) + 1))
#ifndef PH_REP
#define PH_REP 0
#endif
#define REPS(k) for (int _rep = 0; _rep < 1 + ((PH_REP >> (k)) & 1); ++_rep)
#define GRID_BAR() do { if (MK_N_LAUNCHES == 1) xcd_barrier(bar); } while (0)

    if (IN(0)) REPS(0) { p0_prologue(F); if (BOTH(0)) GRID_BAR(); }
    if (IN(1)) REPS(1) {
        DenseOrder So; So.init(S, NIN, D, F.ws + WS_WIN, F.G, (int)blockIdx.x);
        EpiInProj E{(bf16*)(F.ws + WS_A2 + U_Q), (bf16*)(F.ws + WS_A2 + U_K), (bf16*)(F.ws + WS_A2 + U_V), (bf16*)(F.ws + WS_A2 + U_XR), (bf16*)(F.ws + WS_A2 + U_YG), (const float*)(F.ws + WS_ROPEC), (const float*)(F.ws + WS_ROPES)};
        pg8::gemm_phase<EpiInProj, DenseOrder, true>(F.lds, (const char*)(F.ws + WS_A1), D, So, E);
        if (BOTH(1)) GRID_BAR();
    }
    if (IN(2)) REPS(2) {
        { const int u = F.vcu; if (u < S / 64) { lru_unit(F, u); attn_unit(F, u * 64); } }
        if (BOTH(2)) GRID_BAR();
    }
    if (IN(4)) REPS(4) {
        DenseOrder So; So.init(S, D, D, F.ws + WS_WOUT, F.G, (int)blockIdx.x);
        EpiZ E{(float*)(F.ws + WS_A2)};
        pg8::gemm_phase<EpiZ, DenseOrder, true>(F.lds, (const char*)(F.ws + WS_A1), D, So, E);
        if (BOTH(4)) GRID_BAR();
    }
    if (IN(5)) REPS(5) {
        route_phase(F);
        if (BOTH(5)) GRID_BAR();
    }
    if (IN(6)) REPS(6) {
        LAS int* tb = (LAS int*)(F.lds + SCR_OFF); LAS int* cl = tb + 128; LAS int* rb = tb + 256;
        moe_table(F, tb, cl, rb);
        LAS int* ut = tb + 384;
        MoeOrder So{tb, cl, rb, (const int*)(F.ws + WS_TOK), (const char*)(F.ws + WS_WGU), (size_t)512 * D * 2, (size_t)256 * D * 2, 2, F.G, F.vcu, tb[NEX] * 2, D * 2, true, ut};
        So.build(ut, F.tid); __syncthreads();
        EpiAct E{(bf16*)(F.ws + WS_A2)};
        pg8::gemm_phase<EpiAct, MoeOrder, true>(F.lds, (const char*)(F.ws + WS_A1), D, So, E);
        if (BOTH(6)) GRID_BAR();
    }
    if (IN(7)) REPS(7) {
        LAS int* tb = (LAS int*)(F.lds + SCR_OFF); LAS int* cl = tb + 128; LAS int* rb = tb + 256;
        moe_table(F, tb, cl, rb);
        LAS int* ut = tb + 384;
        MoeOrder So{tb, cl, rb, (const int*)(F.ws + WS_TOK), (const char*)(F.ws + WS_WD), (size_t)D * DE * 2, (size_t)256 * DE * 2, 4, F.G, F.vcu, tb[NEX] * 4, DE * 2, false, ut};
        So.build(ut, F.tid); __syncthreads();
        EpiY8 E{F.ws + WS_Y8, F.out, (PROBE_PHASE >= 0 && args.li == 1) ? 1 : 0};
        pg8::gemm_phase<EpiY8, MoeOrder, true>(F.lds, (const char*)(F.ws + WS_A2), DE, So, E);
        if (BOTH(7)) GRID_BAR();
    }
    if (IN(8)) REPS(8) {
        LAS int* tb = (LAS int*)(F.lds + SCR_OFF); LAS int* cl = tb + 128; LAS int* rb = tb + 256;
        moe_table(F, tb, cl, rb);
        combine_rows(F, rb);
    }
#undef IN
#undef BOTH
#undef GRID_BAR
}

extern "C" void kernel_launch(void* const* d_in, const int* in_sizes, int n_in, void* d_out, int out_size, void* d_ws, size_t ws_size, hipStream_t stream) {
    static int grid = 0;
    if (grid == 0) {
        if (n_in != 25 || out_size != S * D || ws_size < WS_END) { fprintf(stderr, "kernel_launch: unexpected shapes (n_in %d out %d ws %zu)\n", n_in, out_size, ws_size); grid = -1; return; }
        int dev = 0, cus = 0, per_cu = 0;
        if (hipGetDevice(&dev) != hipSuccess || hipDeviceGetAttribute(&cus, hipDeviceAttributeMultiprocessorCount, dev) != hipSuccess) { grid = -1; return; }
        if (hipFuncSetAttribute((const void*)fwd, hipFuncAttributeMaxDynamicSharedMemorySize, LDS_BYTES) != hipSuccess) { fprintf(stderr, "kernel_launch: hipFuncSetAttribute failed\n"); grid = -1; return; }
        if (hipOccupancyMaxActiveBlocksPerMultiprocessor(&per_cu, (const void*)fwd, NWAVES * 64, LDS_BYTES) != hipSuccess || per_cu < 1) fprintf(stderr, "kernel_launch: occupancy query says %d\n", per_cu);
        (void)hipGetLastError();
        grid = cus;
          if (grid < S / 64) { fprintf(stderr, "kernel_launch: needs >= %d CUs (one attention/LRU unit per workgroup)\n", S / 64); grid = -1; return; }
    }
    if (grid < 0) return;
    if (hipMemsetAsync((char*)d_ws + WS_CTL, 0, CTL_ZERO_BYTES, stream) != hipSuccess) return;
    Args a{};
    for (int i = 0; i < 25; ++i) a.in[i] = (const float*)d_in[i];
    a.out = (float*)d_out; a.ws = (unsigned char*)d_ws;
    for (int li = 0; li < MK_N_LAUNCHES; ++li) {
        a.ph_lo = (MK_N_LAUNCHES == 1) ? 0 : li; a.ph_hi = (MK_N_LAUNCHES == 1) ? NPHASE : li + 1; a.li = li;
        hipLaunchKernelGGL(fwd, dim3(grid), dim3(NWAVES * 64), LDS_BYTES, stream, a);
    }
#if PROBE_PHASE >= 0
    a.ph_lo = PROBE_PHASE; a.ph_hi = PROBE_PHASE + 1; a.li = 1; a.out = (float*)((unsigned char*)d_ws + WS_Y8);
    hipLaunchKernelGGL(fwd, dim3(grid), dim3(NWAVES * 64), LDS_BYTES, stream, a);
#endif
}
```

```cpp
#include <hip/hip_runtime.h>
#include <cstdio>
#include <cstdint>

#ifndef MK_N_LAUNCHES
#define MK_N_LAUNCHES 1
#endif
#ifndef PROBE_PHASE
#define PROBE_PHASE -1
#endif
#ifndef GEMM_REF
#define GEMM_REF 0
#endif

#define LAS __attribute__((address_space(3)))
#define GAS __attribute__((address_space(1)))
typedef unsigned short bf16;
typedef unsigned v4u __attribute__((ext_vector_type(4)));
typedef unsigned v2u __attribute__((ext_vector_type(2)));
typedef float f32x4 __attribute__((ext_vector_type(4)));
typedef float f32x2 __attribute__((ext_vector_type(2)));
typedef short bf16x8 __attribute__((ext_vector_type(8)));

constexpr int S = 16384, D = 1024, NIN = 1792, AW = 512, KVW = 128, LW = 512, NE = 64, NEX = 65, DE = 256, TOPK = 8;
constexpr int LCAP = 16384;
constexpr float ALPHA = 1.18920711500272f;
constexpr float NORM_EPS = 1e-5f;
constexpr float LOG2E = 1.44269504089f;
constexpr float S_H8 = 8.f, S_WGU = 64.f, S_ACT = 16.f, S_WD = 32.f;
constexpr float QSCALE = 0.125f * 1.44269504089f;
constexpr int NWAVES = 8;
constexpr int NPHASE = 9;

constexpr size_t MiB = 1u << 20;
constexpr size_t WS_CTL = 0, CTL_ZERO_BYTES = 1 * MiB;
constexpr size_t WS_ROPEC = 1 * MiB, WS_ROPES = 3 * MiB;
constexpr size_t WS_AGG = 12 * MiB;
constexpr size_t WS_GW = 15 * MiB;
constexpr size_t WS_WRH = 15 * MiB + 512 * 1024, WS_WRL = 15 * MiB + 768 * 1024;
constexpr int CW_TMO2 = 8;
constexpr size_t WS_RIE = 6 * MiB;
constexpr size_t WS_RIW = 6 * MiB + 512 * 1024;
constexpr size_t WS_TOK = 7 * MiB;
constexpr size_t WS_WIN = 17 * MiB;
constexpr size_t WS_WOUT = 21 * MiB;
constexpr size_t WS_WD = 23 * MiB;
constexpr size_t WS_A2 = 56 * MiB;
constexpr size_t WS_WGU = 136 * MiB;
constexpr size_t WS_A1 = 201 * MiB;
constexpr size_t WS_Y8 = 136 * MiB;
constexpr size_t WS_END = 264 * MiB;
constexpr size_t U_Q = 0, U_K = 16 * MiB, U_V = 20 * MiB, U_XR = 24 * MiB, U_YG = 40 * MiB;
constexpr int CW_BAR = 4096;
constexpr int CW_CNT = 16384;

constexpr int RING_BYTES = 131072;
constexpr int SCR_OFF = RING_BYTES, SCR_BYTES = 20480;
constexpr int MISC_OFF = SCR_OFF + SCR_BYTES;
constexpr int LDS_BYTES = MISC_OFF + 512;

__device__ __forceinline__ float bf2f(unsigned b) { return __uint_as_float(b << 16); }
__device__ __forceinline__ unsigned f2bf(float f) { unsigned u = __float_as_uint(f); return (u + 0x7fffu + ((u >> 16) & 1u)) >> 16; }
__device__ __forceinline__ unsigned pk2(float lo, float hi) { return f2bf(lo) | (f2bf(hi) << 16); }
__device__ __forceinline__ float fast_exp(float x) { return __builtin_amdgcn_exp2f(x * 1.44269504089f); }
__device__ __forceinline__ float sigmoidf_(float x) { return __builtin_amdgcn_rcpf(1.0f + fast_exp(-x)); }

namespace pg8 {
constexpr int BM = 256, BK = 64, HALF = 128, HTB = HALF * BK * 2, STAGE_BYTES = 8 * HTB, NXCD = 8, WGM = 8;
__host__ __device__ __forceinline__ int lds_byte(int r, int c) { const int st = (r >> 4) * 2 + (c >> 5), rr = r & 15, cc = c & 31, ob = rr * 64 + cc * 2; return st * 1024 + (ob ^ (((ob >> 9) & 1) << 5)); }
__host__ __device__ __forceinline__ void stage_rc(int b, int& R, int& C) { const int st = b / 1024, sb = b % 1024, swz = sb ^ (((sb >> 9) & 1) << 5); R = (st >> 1) * 16 + swz / 64; C = (st & 1) * 32 + (swz % 64) / 2; }
__host__ __device__ __forceinline__ int perm32(int rho) { const int n = rho >> 4, i = rho & 15; return 8 * (i >> 2) + 4 * n + (i & 3); }

struct Unit { const char* B; int row0; int slot0; int pn; int e; int cnt; int y0; };

typedef int i32x8 __attribute__((ext_vector_type(8)));
__device__ __forceinline__ i32x8 cat8(bf16x8 lo, bf16x8 hi) { const v4u a = __builtin_bit_cast(v4u, lo), b = __builtin_bit_cast(v4u, hi); return (i32x8){(int)a.x, (int)a.y, (int)a.z, (int)a.w, (int)b.x, (int)b.y, (int)b.z, (int)b.w}; }
__device__ __forceinline__ unsigned cvt_pk_bf16(float lo, float hi) { unsigned r; asm volatile("v_cvt_pk_bf16_f32 %0, %1, %2" : "=v"(r) : "v"(lo), "v"(hi)); return r; }

#if GEMM_REF
template <class Epi, class Sched, bool ALIGN_EPI>
__device__ __forceinline__ void gemm_phase(LAS unsigned char* lds, const char* Abase, const int K, const Sched& S, const Epi& E) {
    const int tid = threadIdx.x, wid = __builtin_amdgcn_readfirstlane(tid >> 6), lane = tid & 63, wr = wid >> 2, wc = wid & 3, fr = lane & 15, fq = lane >> 4;
    Unit cur;
    for (int ui = 0; S.next(ui, cur); ++ui) {
        f32x4 acc[2][2][4][2];
#pragma unroll
        for (int ai = 0; ai < 2; ++ai)
#pragma unroll
            for (int bj = 0; bj < 2; ++bj)
#pragma unroll
                for (int m = 0; m < 4; ++m)
#pragma unroll
                    for (int n = 0; n < 2; ++n)
#pragma unroll
                        for (int j = 0; j < 4; ++j) {
                            const int row = ai * 128 + wr * 64 + m * 16 + fr;
                            const int col = bj * 128 + wc * 32 + (Epi::PERM ? (8 * fq + 4 * n + j) : (16 * n + 4 * fq + j));
                            const bf16* a = (const bf16*)(Abase + S.aoff(cur, row)); const bf16* b = (const bf16*)(cur.B) + (size_t)col * K;
                            float s = 0.f;
                            for (int k = 0; k < K; k += 8) { const v4u av = *(const v4u*)(a + k), bv = *(const v4u*)(b + k);
#pragma unroll
                                for (int q = 0; q < 4; ++q) { s += bf2f(av[q] & 0xffffu) * bf2f(bv[q] & 0xffffu); s += bf2f(av[q] >> 16) * bf2f(bv[q] >> 16); } }
                            acc[ai][bj][m][n][j] = s;
                        }
        E(acc, cur, wr, wc, fr, fq);
    }
    __syncthreads();
}
#else
template <class Epi, class Sched, bool ALIGN_EPI, bool FP8 = false>
__device__ __forceinline__ void gemm_phase(LAS unsigned char* lds, const char* Abase, const int K_, const Sched& S, const Epi& E) {
    const int tid = threadIdx.x, wid = __builtin_amdgcn_readfirstlane(tid >> 6), lane = tid & 63, wr = wid >> 2, wc = wid & 3, fr = lane & 15, fq = lane >> 4;
    int K = K_; asm volatile("" : "+s"(K));
    const int nt = K / BK;
    int RA[2]; unsigned CA2[2], voffB[2];
#pragma unroll
    for (int i = 0; i < 2; ++i) { int R, C; stage_rc(tid * 16 + i * 8192, R, C); const int Rb = Epi::PERM ? ((R & ~31) + perm32(R & 31)) : R;
        RA[i] = R; CA2[i] = (unsigned)C * 2u; voffB[i] = (unsigned)(Rb * K + C) * 2u; }
    const size_t kstep = (size_t)(BK * 2);
    const size_t hstep = (size_t)HALF * K * 2;
    const unsigned ldsw = (unsigned)wid * 1024u;
    const int aoff = lds_byte(wr * 64 + fr, fq * (FP8 ? 16 : 8)), boff = lds_byte(wc * 32 + fr, fq * (FP8 ? 16 : 8));
#define PG8_SA(b, h) (((b) * 2 + (h)) * HTB)
#define PG8_SB(b, h) ((4 + (b) * 2 + (h)) * HTB)
#define PG8_STAGE(bufoff, gbase, voff) do { _Pragma("unroll") for (int _i = 0; _i < 2; ++_i) \
        __builtin_amdgcn_global_load_lds((const unsigned*)((const char*)(gbase) + (voff)[_i]), (LAS unsigned*)(lds + (bufoff) + ldsw + _i * 8192), 16, 0, 0); } while (0)
#define PG8_LD8(p) ({ const v4u _lo = *(const LAS v4u*)(p), _hi = *(const LAS v4u*)((p) + 16); (i32x8){(int)_lo.x, (int)_lo.y, (int)_lo.z, (int)_lo.w, (int)_hi.x, (int)_hi.y, (int)_hi.z, (int)_hi.w}; })
#define PG8_LDA(dst, b, h) do { _Pragma("unroll") for (int m = 0; m < 4; ++m) { if constexpr (FP8) dst##8[m] = PG8_LD8(lds + PG8_SA(b, h) + aoff + m * 2048); \
        else { _Pragma("unroll") for (int k = 0; k < 2; ++k) dst[m][k] = *(const LAS bf16x8*)(lds + PG8_SA(b, h) + aoff + m * 2048 + k * 1024); } } } while (0)
#define PG8_LDB(dst, b, h) do { _Pragma("unroll") for (int n = 0; n < 2; ++n) { if constexpr (FP8) dst##8[n] = PG8_LD8(lds + PG8_SB(b, h) + boff + n * 2048); \
        else { _Pragma("unroll") for (int k = 0; k < 2; ++k) dst[n][k] = *(const LAS bf16x8*)(lds + PG8_SB(b, h) + boff + n * 2048 + k * 1024); } } } while (0)
#define PG8_MMA(ai, bj, At, Bt) do { __builtin_amdgcn_s_setprio(1); _Pragma("unroll") for (int m = 0; m < 4; ++m) _Pragma("unroll") for (int n = 0; n < 2; ++n) { \
        if constexpr (FP8) acc[ai][bj][m][n] = __builtin_amdgcn_mfma_scale_f32_16x16x128_f8f6f4(Bt##8[n], At##8[m], acc[ai][bj][m][n], 0, 0, 0, 0x7f7f7f7f, 0, 0x7f7f7f7f); \
        else { _Pragma("unroll") for (int k = 0; k < 2; ++k) acc[ai][bj][m][n] = __builtin_amdgcn_mfma_f32_16x16x32_bf16(Bt[n][k], At[m][k], acc[ai][bj][m][n], 0, 0, 0); } } __builtin_amdgcn_s_setprio(0); } while (0)
#define PG8_WAIT_V(n) asm volatile("s_waitcnt vmcnt(" #n ")" ::: "memory")
#define PG8_WAIT_L(n) asm volatile("s_waitcnt lgkmcnt(" #n ")" ::: "memory")
#define PG8_BAR __builtin_amdgcn_s_barrier()
#define PG8_SCHED __builtin_amdgcn_sched_barrier(0)
    Unit cur, nxt; int ui = 0;
    if (!S.next(0, cur)) return;
    unsigned curA[2][2], nxtA[2][2];
#pragma unroll
    for (int h = 0; h < 2; ++h)
#pragma unroll
        for (int i = 0; i < 2; ++i) curA[h][i] = S.aoff(cur, h * HALF + RA[i]) + CA2[i];
    f32x4 acc[2][2][4][2];
#pragma unroll
    for (int a = 0; a < 2; ++a)
#pragma unroll
        for (int b = 0; b < 2; ++b)
#pragma unroll
            for (int m = 0; m < 4; ++m)
#pragma unroll
                for (int n = 0; n < 2; ++n) acc[a][b][m][n] = (f32x4){0.f, 0.f, 0.f, 0.f};
    bf16x8 At[4][2], B0[2][2], B1[2][2]; i32x8 At8[4], B08[2], B18[2];
    const char* cB = cur.B;
    PG8_STAGE(PG8_SB(0, 0), cB, voffB); PG8_STAGE(PG8_SB(0, 1), cB + hstep, voffB); PG8_STAGE(PG8_SA(0, 0), Abase, curA[0]); PG8_STAGE(PG8_SA(0, 1), Abase, curA[1]);
    if (wr == 1) PG8_BAR;
    PG8_WAIT_V(2); PG8_BAR;
    PG8_STAGE(PG8_SB(1, 0), cB + kstep, voffB); PG8_STAGE(PG8_SA(1, 0), Abase + kstep, curA[0]); PG8_STAGE(PG8_SB(1, 1), cB + hstep + kstep, voffB);
    PG8_WAIT_V(6); PG8_BAR;
    for (;;) {
        const bool has_next = S.next(ui + 1, nxt);
#pragma unroll
        for (int h = 0; h < 2; ++h)
#pragma unroll
            for (int i = 0; i < 2; ++i) nxtA[h][i] = has_next ? (S.aoff(nxt, h * HALF + RA[i]) + CA2[i]) : curA[h][i];
        const char* nB = has_next ? nxt.B : cB;
        for (int t = 0; t < nt; t += 2) {
            const bool last = (t == nt - 2);
            const char* a1 = Abase + (size_t)(t + 1) * kstep;
            const char* a2 = Abase + (last ? (size_t)0 : (size_t)(t + 2) * kstep); const char* b2 = last ? nB : cB + (size_t)(t + 2) * kstep;
            const char* a3 = a2 + kstep; const char* b3 = b2 + kstep;
            PG8_LDB(B0, 0, 0); PG8_LDB(B1, 0, 1); PG8_SCHED; PG8_LDA(At, 0, 0); PG8_STAGE(PG8_SA(1, 1), a1, curA[1]);
            if (last) {
#pragma unroll
                for (int h = 0; h < 2; ++h)
#pragma unroll
                    for (int i = 0; i < 2; ++i) curA[h][i] = nxtA[h][i]; }
            PG8_WAIT_V(8); PG8_WAIT_L(0); PG8_BAR; PG8_MMA(0, 0, At, B0); PG8_MMA(0, 1, At, B1); PG8_BAR; PG8_SCHED;
            PG8_LDA(At, 0, 1); PG8_STAGE(PG8_SB(0, 0), b2, voffB); PG8_STAGE(PG8_SB(0, 1), b2 + hstep, voffB); PG8_STAGE(PG8_SA(0, 0), a2, curA[0]);
            PG8_WAIT_V(8); PG8_WAIT_L(0); PG8_BAR; PG8_MMA(1, 0, At, B0); PG8_MMA(1, 1, At, B1); PG8_BAR; PG8_SCHED;
            PG8_LDB(B0, 1, 0); PG8_LDB(B1, 1, 1); PG8_SCHED; PG8_LDA(At, 1, 0); PG8_STAGE(PG8_SA(0, 1), a2, curA[1]);
            PG8_WAIT_V(8); PG8_WAIT_L(0); PG8_BAR; PG8_MMA(0, 0, At, B0); PG8_MMA(0, 1, At, B1); PG8_BAR; PG8_SCHED;
            PG8_LDA(At, 1, 1); PG8_STAGE(PG8_SB(1, 0), b3, voffB); PG8_STAGE(PG8_SB(1, 1), b3 + hstep, voffB); PG8_STAGE(PG8_SA(1, 0), a3, curA[0]);
            PG8_WAIT_V(8); PG8_WAIT_L(0); PG8_BAR; PG8_MMA(1, 0, At, B0); PG8_MMA(1, 1, At, B1); PG8_BAR; PG8_SCHED;
        }
        if constexpr (ALIGN_EPI) { if (wr == 0) PG8_BAR; }
        E(acc, cur, wr, wc, fr, fq);
        if (!has_next) break;
#pragma unroll
        for (int a = 0; a < 2; ++a)
#pragma unroll
            for (int b = 0; b < 2; ++b)
#pragma unroll
                for (int m = 0; m < 4; ++m)
#pragma unroll
                    for (int n = 0; n < 2; ++n) acc[a][b][m][n] = (f32x4){0.f, 0.f, 0.f, 0.f};
        cur = nxt; cB = nB; ++ui;
        if constexpr (ALIGN_EPI) { if (wr == 1) PG8_BAR; }
    }
    PG8_WAIT_V(0);
    if constexpr (!ALIGN_EPI) { if (wr == 0) PG8_BAR; }
    PG8_BAR;
#undef PG8_SA
#undef PG8_SB
#undef PG8_STAGE
#undef PG8_LDA
#undef PG8_LDB
#undef PG8_MMA
#undef PG8_WAIT_V
#undef PG8_WAIT_L
#undef PG8_BAR
#undef PG8_SCHED
}
#endif
}

#define XB_TMO      128
#define XB_XCNT(j)  (256  + 64 * (j))
#define XB_XSUB(j)  (1280 + 64 * (j))
#define XB_XGEN(j)  (2304 + 64 * (j))
#define XB_TOP      3328
#define XB_TOPGEN   3392
#define XCD_BAR_WORDS 3456
#define XB_SPIN_CAP (1u << 18)
__device__ __forceinline__ unsigned xb_ld(unsigned* p)              { return __hip_atomic_load(p, __ATOMIC_RELAXED, __HIP_MEMORY_SCOPE_AGENT); }
__device__ __forceinline__ unsigned xb_add(unsigned* p, unsigned v) { return __hip_atomic_fetch_add(p, v, __ATOMIC_RELAXED, __HIP_MEMORY_SCOPE_AGENT); }
__device__ __forceinline__ unsigned xb_xcc_id() { return (unsigned)__builtin_amdgcn_s_getreg((3 << 11) | 20) & 0xFu; }
#define XB_SPIN(cond, bar) do { unsigned _sp = 0; while (cond) { __builtin_amdgcn_s_sleep(1); \
    if ((++_sp & 255u) == 0u) { if (xb_ld(&(bar)[XB_TMO])) break; if (_sp > XB_SPIN_CAP) { atomicAdd(&(bar)[XB_TMO], 1u); break; } } } } while (0)
struct XcdBarrier { unsigned* bar; unsigned x; volatile LAS unsigned* st; };
__device__ __forceinline__ XcdBarrier xcd_barrier_post(unsigned* bar, volatile LAS unsigned* st) {
    XcdBarrier b; b.bar = bar; b.x = xb_xcc_id(); b.st = st;
    if (threadIdx.x == 0) (void)xb_add(&bar[XB_XCNT(b.x)], 1u);
    return b;
}
__device__ __forceinline__ void xcd_barrier_complete(unsigned* bar, unsigned x, unsigned& nloc, unsigned& nx) {
    const unsigned G = gridDim.x * gridDim.y * gridDim.z;
    unsigned sum, cnt, mine, sp = 0u;
    for (;;) {
        sum = 0u; cnt = 0u; mine = 0u;
#pragma unroll
        for (unsigned j = 0; j < 16; ++j) { const unsigned c = xb_ld(&bar[XB_XCNT(j)]); sum += c; cnt += (c > 0u) ? 1u : 0u; mine = (j == x) ? c : mine; }
        if (sum == G) break;
        __builtin_amdgcn_s_sleep(1);
        if ((++sp & 255u) == 0u) { if (xb_ld(&bar[XB_TMO])) break; if (sp > XB_SPIN_CAP) { atomicAdd(&bar[XB_TMO], 1u); break; } }
    }
    nloc = mine > 0u ? mine : 1u; nx = cnt > 0u ? cnt : 1u;
}
__device__ __forceinline__ void xcd_barrier(const XcdBarrier& b) {
    asm volatile("s_waitcnt vmcnt(0)" ::: "memory");
    __syncthreads();
    if (threadIdx.x == 0) {
        unsigned* bar = b.bar;
        __builtin_amdgcn_s_waitcnt(0);
        unsigned nloc = b.st[0], nx = b.st[1];
        if (nloc == 0u) { xcd_barrier_complete(bar, b.x, nloc, nx); b.st[0] = nloc; b.st[1] = nx; }
        const unsigned old = xb_add(&bar[XB_XSUB(b.x)], 1u);
        const unsigned gen = old / nloc;
        if (old + 1u == (gen + 1u) * nloc) {
            __builtin_amdgcn_fence(__ATOMIC_RELEASE, "agent");
            asm volatile("s_waitcnt vmcnt(0)" ::: "memory");
            const unsigned og = xb_add(&bar[XB_TOP], 1u);
            const unsigned tg = og / nx;
            if (og + 1u == (tg + 1u) * nx) xb_add(&bar[XB_TOPGEN], 1u);
            else XB_SPIN(xb_ld(&bar[XB_TOPGEN]) == tg, bar);
            __builtin_amdgcn_fence(__ATOMIC_ACQUIRE, "agent");
            xb_add(&bar[XB_XGEN(b.x)], 1u);
            asm volatile("s_waitcnt vmcnt(0)" ::: "memory");
        } else {
            XB_SPIN(xb_ld(&bar[XB_XGEN(b.x)]) == gen, bar);
            __builtin_amdgcn_fence(__ATOMIC_ACQUIRE, "agent");
            asm volatile("s_waitcnt vmcnt(0)" ::: "memory");
        }
    }
    __syncthreads();
}

struct Frame {
    LAS unsigned char* lds;
    volatile LAS unsigned* MISC;
    unsigned* ctl;
    int tid, lane, wave, vcu, G;
    const float* in[25]; float* out; unsigned char* ws;
};
enum { I_X = 0, I_WIN, I_CONVW, I_CONVB, I_WRG, I_BRG, I_WIG, I_BIG, I_LAM, I_SINKS, I_GATTN, I_GLRU, I_WOUT, I_LN1G, I_LN1B, I_WROUTER, I_EBIAS, I_WGATE, I_WUP, I_WDOWN, I_WSGATE, I_WSUP, I_WSDOWN, I_LN2G, I_LN2B };

__device__ __forceinline__ float wave_sum(float v) {
#pragma unroll
    for (int o = 1; o < 64; o <<= 1) v += __shfl_xor(v, o);
    return v;
}
#define LDS_WAIT() asm volatile("s_waitcnt lgkmcnt(0)" ::: "memory")

template <class RowMap>
__device__ __forceinline__ void p0_transpose_item(const float* W, int K, int ldw, bf16* WT, const RowMap& rm, LAS float* scr, int item, int lane) {
    const int nblk = ldw / 32, kb = item / nblk, nb = item % nblk, k0 = 64 * kb, n0 = 32 * nb;
#pragma unroll 8
    for (int i = 0; i < 32; ++i) { const int kk = 2 * i + (lane >> 5); scr[kk * 33 + (lane & 31)] = W[(size_t)(k0 + kk) * ldw + n0 + (lane & 31)]; }
    LDS_WAIT(); asm volatile("" ::: "memory");
    const int c = lane & 7;
#pragma unroll
    for (int j = 0; j < 4; ++j) { const int n = (lane >> 3) + 8 * j; const LAS float* s = scr + (8 * c) * 33 + n;
        v4u o; o.x = pk2(s[0 * 33], s[1 * 33]); o.y = pk2(s[2 * 33], s[3 * 33]); o.z = pk2(s[4 * 33], s[5 * 33]); o.w = pk2(s[6 * 33], s[7 * 33]);
        *(v4u*)(WT + (size_t)rm(n0 + n) * K + k0 + 8 * c) = o; }
    LDS_WAIT(); asm volatile("" ::: "memory");
}
template <class RowMap>
__device__ __forceinline__ void p0_transpose_item8(const float* W, int K, int ldw, unsigned char* WT, const RowMap& rm, LAS float* scr, int item, int lane, float qs) {
    const int nblk = ldw / 32, kb = item / nblk, nb = item % nblk, k0 = 64 * kb, n0 = 32 * nb;
#pragma unroll 8
    for (int i = 0; i < 32; ++i) { const int kk = 2 * i + (lane >> 5); scr[kk * 33 + (lane & 31)] = W[(size_t)(k0 + kk) * ldw + n0 + (lane & 31)] * qs; }
    LDS_WAIT(); asm volatile("" ::: "memory");
    const int c = lane & 3;
#pragma unroll
    for (int j = 0; j < 2; ++j) { const int n = (lane >> 2) + 16 * j; const LAS float* sp = scr + (16 * c) * 33 + n;
        v4u o;
#pragma unroll
        for (int q = 0; q < 4; ++q) { int p = 0; p = __builtin_amdgcn_cvt_pk_fp8_f32(sp[(4 * q) * 33], sp[(4 * q + 1) * 33], p, false); p = __builtin_amdgcn_cvt_pk_fp8_f32(sp[(4 * q + 2) * 33], sp[(4 * q + 3) * 33], p, true); o[q] = (unsigned)p; }
        *(v4u*)(WT + (size_t)rm(n0 + n) * K + k0 + 16 * c) = o; }
    LDS_WAIT(); asm volatile("" ::: "memory");
}
struct MapIn {
    __device__ __forceinline__ int operator()(int n) const {
        if (n >= AW + KVW) return n;
        const int d = n & 63, p = 32 * ((d >> 4) & 1) + 8 * ((d >> 2) & 3) + 4 * (d >> 5) + (d & 3);
        return (n & ~63) + p;
    }
};
struct MapId { int off; __device__ __forceinline__ int operator()(int n) const { return off + n; } };
struct MapDown { __device__ __forceinline__ int operator()(int n) const {
        const int lg = n & 255, wc = lg >> 6, fq = (lg >> 4) & 3, bj = (lg >> 3) & 1, nn = (lg >> 2) & 1, j = lg & 3;
        return (n & ~255) + 128 * bj + 32 * wc + 8 * fq + 4 * nn + j; } };
struct MapGU { int up; __device__ __forceinline__ int operator()(int n) const { return (n >> 7) * 256 + up * 128 + (n & 127); } };

__device__ __forceinline__ void p0_prologue(Frame& F) {
    LAS float* scr = (LAS float*)(F.lds + F.wave * 16384);
    const int gw = F.vcu * NWAVES + F.wave, NGW = F.G * NWAVES;
    { bf16* Xb = (bf16*)(F.ws + WS_A1); const float* x = F.in[I_X];
      for (int m = gw; m < S; m += NGW) { const f32x4* xr = (const f32x4*)(x + (size_t)m * D) + F.lane; v2u* o = (v2u*)(Xb + (size_t)m * D) + F.lane;
#pragma unroll
          for (int j = 0; j < 4; ++j) { const f32x4 v = xr[64 * j]; v2u w; w.x = pk2(v.x, v.y); w.y = pk2(v.z, v.w); o[64 * j] = w; } } }
    {
        constexpr int I_IN = (D / 64) * (NIN / 32), I_OUT = (D / 64) * (D / 32), I_G = (D / 64) * (DE / 32), I_DN = (DE / 64) * (D / 32);
        constexpr int PER_E = 2 * I_G + I_DN;
        constexpr int NITEMS = I_IN + I_OUT + NEX * PER_E;
        bf16* WinT = (bf16*)(F.ws + WS_WIN); bf16* WoutT = (bf16*)(F.ws + WS_WOUT); unsigned char* WguT = F.ws + WS_WGU; unsigned char* WdT = F.ws + WS_WD;
        for (int it = gw; it < NITEMS; it += NGW) {
            int r = it;
            if (r < I_IN) { p0_transpose_item(F.in[I_WIN], D, NIN, WinT, MapIn{}, scr, r, F.lane); continue; } r -= I_IN;
            if (r < I_OUT) { p0_transpose_item(F.in[I_WOUT], D, D, WoutT, MapId{0}, scr, r, F.lane); continue; } r -= I_OUT;
            const int e = r / PER_E; r -= e * PER_E;
            const float* wg = e < NE ? F.in[I_WGATE] + (size_t)e * D * DE : F.in[I_WSGATE];
            const float* wu = e < NE ? F.in[I_WUP] + (size_t)e * D * DE : F.in[I_WSUP];
            const float* wd = e < NE ? F.in[I_WDOWN] + (size_t)e * DE * D : F.in[I_WSDOWN];
            if (r < I_G) { p0_transpose_item8(wg, D, DE, WguT + (size_t)e * 512 * D, MapGU{0}, scr, r, F.lane, S_WGU); continue; } r -= I_G;
            if (r < I_G) { p0_transpose_item8(wu, D, DE, WguT + (size_t)e * 512 * D, MapGU{1}, scr, r, F.lane, S_WGU); continue; } r -= I_G;
            p0_transpose_item8(wd, DE, D, WdT + (size_t)e * D * DE, MapDown{}, scr, r, F.lane, S_WD);
        }
    }
    {
        const int gt = F.vcu * 512 + F.tid, NGT = F.G * 512;
        float* rc = (float*)(F.ws + WS_ROPEC); float* rs = (float*)(F.ws + WS_ROPES);
        for (int i = gt; i < (S / 64) * 32; i += NGT) { const int tb = i >> 5, f = i & 31;
            const double inv = exp(-(double)f * (9.210340371976184 / 32.0));
            double c = cos((double)(tb * 64) * inv), sn = sin((double)(tb * 64) * inv); const double cs = cos(inv), ss = sin(inv);
            for (int k = 0; k < 64; ++k) { rc[(tb * 64 + k) * 32 + f] = (float)c; rs[(tb * 64 + k) * 32 + f] = (float)sn; const double c2 = c * cs - sn * ss; sn = sn * cs + c * ss; c = c2; } }
        int* tok = (int*)(F.ws + WS_TOK);
        for (int i = gt; i < NEX * LCAP; i += NGT) { const bool sh = i >= NE * LCAP; tok[i] = sh ? (i - NE * LCAP) : 0; }
        if (gt == 0) F.ctl[CW_CNT + 16 * NE] = (unsigned)S;
        bf16* gw = (bf16*)(F.ws + WS_GW);
        for (int i = gt; i < 2 * 8 * 4096; i += NGT) { const int g = i >> 15, n = (i >> 12) & 7, j = (i >> 6) & 63, ii = i & 63;
            gw[i] = (bf16)f2bf((g ? F.in[I_WIG] : F.in[I_WRG])[n * 4096 + ii * 64 + j]); }
        { bf16* wrh = (bf16*)(F.ws + WS_WRH); bf16* wrl = (bf16*)(F.ws + WS_WRL); const float* wr = F.in[I_WROUTER];
          for (int i = gt; i < NE * D; i += NGT) { const int e = i >> 10, k = i & 1023; const float w = wr[(size_t)k * NE + e]; const unsigned hi = f2bf(w); wrh[i] = (bf16)hi; wrl[i] = (bf16)f2bf(w - bf2f(hi)); } }
        unsigned* ag = (unsigned*)(F.ws + WS_AGG);
        for (int i = gt; i < (256 + 16) * LW * 2 * 2; i += NGT) ag[i] = 0u;
    }
}

struct DenseOrder {
    int nM, nN, nwg, G, c, K2; const char* Bt;
    __device__ void init(int M, int N, int K, const void* Bt_, int G_, int c_) { nM = M / 256; nN = N / 256; nwg = nM * nN; G = G_; c = c_; K2 = K * 2; Bt = (const char*)Bt_; }
    __device__ __forceinline__ bool next(int i, pg8::Unit& u) const {
        const long L = (long)i * G + c; if (L >= nwg) return false;
        int wgid = (int)L; { const int q = nwg / 8, r = nwg % 8, xcd = wgid % 8, off = wgid / 8; wgid = (xcd < r ? xcd * (q + 1) : r * (q + 1) + (xcd - r) * q) + off; }
        const int nig = 8 * nN, gid = wgid / nig, fm = gid * 8, gsz = (nM - fm) < 8 ? (nM - fm) : 8;
        const int pm = fm + ((wgid % nig) % gsz), pn = (wgid % nig) / gsz;
        u.B = Bt + (size_t)pn * 256 * K2; u.row0 = pm * 256; u.slot0 = 0; u.pn = pn; u.e = 0; u.cnt = 256; u.y0 = 0; return true;
    }
    __device__ __forceinline__ unsigned aoff(const pg8::Unit& u, int r) const { return (unsigned)(u.row0 + r) * (unsigned)K2; }
};
struct MoeOrder {
    const LAS int* tb; const LAS int* cl; const LAS int* rb; const int* tok; const char* Bt; size_t bstride_e, bstride_pn; int npn, G, c, total, K2; bool gather;
    const LAS int* ut;
    __device__ __forceinline__ void build(LAS int* utw, int tid) const {
        if (tid < 16) {
            const int L = tid * G + c; int v0 = 0, T = 0, j = 0;
            if (L < total) {
                const int pn = L % npn; T = L / npn;
                int e = 0;
                for (int s = 32; s >= 1; s >>= 1) { const int e2 = e + s; if (e2 <= NE && tb[e2] <= T) e = e2; }
                if (e + 1 <= NE && tb[e + 1] <= T) e = e + 1;
                j = T - tb[e]; v0 = e | (pn << 8) | (1 << 16);
            }
            utw[4 * tid] = v0; utw[4 * tid + 1] = T; utw[4 * tid + 2] = j; utw[4 * tid + 3] = 0;
        }
    }
    __device__ __forceinline__ bool next(int i, pg8::Unit& u) const {
        if (i >= 16) return false;
        const int v0 = __builtin_amdgcn_readfirstlane(ut[4 * i]); if (!(v0 >> 16)) return false;
        const int T = __builtin_amdgcn_readfirstlane(ut[4 * i + 1]), j = __builtin_amdgcn_readfirstlane(ut[4 * i + 2]);
        const int e = v0 & 255, pn = (v0 >> 8) & 255;
        u.e = e; u.pn = pn; u.row0 = T * 256; u.slot0 = e * LCAP + j * 256; u.cnt = __builtin_amdgcn_readfirstlane(cl[e]) - j * 256; u.y0 = __builtin_amdgcn_readfirstlane(rb[e]) + j * 256;
        u.B = Bt + (size_t)e * bstride_e + (size_t)pn * bstride_pn; return true;
    }
    __device__ __forceinline__ unsigned aoff(const pg8::Unit& u, int r) const {
        if (gather) return (unsigned)tok[u.slot0 + r] * (unsigned)K2;
        return (unsigned)(u.row0 + r) * (unsigned)K2;
    }
};

struct EpiInProj {
    static constexpr bool PERM = true;
    bf16 *Q, *Kb, *V, *XR, *YG; const float *rc, *rs;
    __device__ __forceinline__ void operator()(const f32x4 (&acc)[2][2][4][2], const pg8::Unit& u, int wr, int wc, int fr, int fq) const {
        const int pn = u.pn;
#pragma unroll
        for (int ai = 0; ai < 2; ++ai)
#pragma unroll
            for (int m = 0; m < 4; ++m) {
                const size_t row = (size_t)(u.row0 + ai * 128 + wr * 64 + m * 16 + fr);
#pragma unroll
                for (int bj = 0; bj < 2; ++bj) {
                    const f32x4 v0 = acc[ai][bj][m][0], v1 = acc[ai][bj][m][1];
                    if (pn < 2 || (pn == 2 && bj == 0)) {
                        const int d0 = 16 * (wc & 1) + 4 * fq;
                        const f32x4 c = *(const f32x4*)(rc + row * 32 + d0), s = *(const f32x4*)(rs + row * 32 + d0);
                        f32x4 o1 = v0 * c - v1 * s, o2 = v1 * c + v0 * s;
                        bf16* dst;
                        if (pn < 2) { o1 = o1 * QSCALE; o2 = o2 * QSCALE; dst = Q + row * AW + pn * 256 + bj * 128 + (wc >> 1) * 64; }
                        else dst = Kb + row * KVW + (wc >> 1) * 64;
                        v2u w1, w2; w1.x = pg8::cvt_pk_bf16(o1[0], o1[1]); w1.y = pg8::cvt_pk_bf16(o1[2], o1[3]); w2.x = pg8::cvt_pk_bf16(o2[0], o2[1]); w2.y = pg8::cvt_pk_bf16(o2[2], o2[3]);
                        *(v2u*)(dst + d0) = w1; *(v2u*)(dst + 32 + d0) = w2;
                    } else {
                        bf16* dst;
                        if (pn == 2) dst = V + row * KVW + wc * 32 + 8 * fq;
                        else if (pn < 5) dst = XR + row * LW + (pn - 3) * 256 + bj * 128 + wc * 32 + 8 * fq;
                        else dst = YG + row * LW + (pn - 5) * 256 + bj * 128 + wc * 32 + 8 * fq;
                        v4u w; w.x = pg8::cvt_pk_bf16(v0[0], v0[1]); w.y = pg8::cvt_pk_bf16(v0[2], v0[3]); w.z = pg8::cvt_pk_bf16(v1[0], v1[1]); w.w = pg8::cvt_pk_bf16(v1[2], v1[3]);
                        *(v4u*)dst = w;
                    }
                }
            }
    }
};
struct EpiZ {
    static constexpr bool PERM = false;
    float* Z;
    __device__ __forceinline__ void operator()(const f32x4 (&acc)[2][2][4][2], const pg8::Unit& u, int wr, int wc, int fr, int fq) const {
#pragma unroll
        for (int ai = 0; ai < 2; ++ai)
#pragma unroll
            for (int m = 0; m < 4; ++m) {
                const size_t off = (size_t)(u.row0 + ai * 128 + wr * 64 + m * 16 + fr) * D + u.pn * 256 + wc * 32 + 4 * fq;
#pragma unroll
                for (int bj = 0; bj < 2; ++bj)
#pragma unroll
                    for (int n = 0; n < 2; ++n) *(f32x4*)(Z + off + bj * 128 + n * 16) = acc[ai][bj][m][n];
            }
    }
};
__device__ __forceinline__ float silu_mul(float g, float u) { return g * u * __builtin_amdgcn_rcpf(1.0f + fast_exp(-g)); }
struct EpiAct {
    static constexpr bool PERM = true;
    unsigned char* ACT;
    __device__ __forceinline__ void operator()(const f32x4 (&acc)[2][2][4][2], const pg8::Unit& u, int wr, int wc, int fr, int fq) const {
        constexpr float SI = 1.0f / (S_H8 * S_WGU);
#pragma unroll
        for (int ai = 0; ai < 2; ++ai)
#pragma unroll
            for (int m = 0; m < 4; ++m) {
                const size_t row = (size_t)(u.row0 + ai * 128 + wr * 64 + m * 16 + fr);
                const f32x4 g0 = acc[ai][0][m][0] * SI, g1 = acc[ai][0][m][1] * SI, u0 = acc[ai][1][m][0] * (SI * S_ACT), u1 = acc[ai][1][m][1] * (SI * S_ACT);
                v2u w; int p = 0;
                p = __builtin_amdgcn_cvt_pk_fp8_f32(silu_mul(g0[0], u0[0]), silu_mul(g0[1], u0[1]), p, false); p = __builtin_amdgcn_cvt_pk_fp8_f32(silu_mul(g0[2], u0[2]), silu_mul(g0[3], u0[3]), p, true); w.x = (unsigned)p;
                p = __builtin_amdgcn_cvt_pk_fp8_f32(silu_mul(g1[0], u1[0]), silu_mul(g1[1], u1[1]), p, false); p = __builtin_amdgcn_cvt_pk_fp8_f32(silu_mul(g1[2], u1[2]), silu_mul(g1[3], u1[3]), p, true); w.y = (unsigned)p;
                *(v2u*)(ACT + row * DE + u.pn * 128 + wc * 32 + 8 * fq) = w;
            }
    }
};
struct EpiY8 {
    static constexpr bool PERM = true;
    unsigned char* Y; float* out; int probe;
    __device__ __forceinline__ void operator()(const f32x4 (&acc)[2][2][4][2], const pg8::Unit& u, int wr, int wc, int fr, int fq) const {
        const int colb = u.pn * 256 + 64 * wc + 16 * fq;
        if (u.e == NE) {
            if (probe) return;
#pragma unroll
            for (int ai = 0; ai < 2; ++ai)
#pragma unroll
                for (int m = 0; m < 4; ++m) {
                    const int r = ai * 128 + wr * 64 + m * 16 + fr;
                    float* o = out + (size_t)((u.slot0 - NE * LCAP) + r) * D + colb;
#pragma unroll
                    for (int bj = 0; bj < 2; ++bj)
#pragma unroll
                        for (int n = 0; n < 2; ++n) { f32x4 v = *(f32x4*)(o + 8 * bj + 4 * n); v = v + acc[ai][bj][m][n] * (1.0f / (S_ACT * S_WD)); *(f32x4*)(o + 8 * bj + 4 * n) = v; }
                    asm volatile("" ::: "memory");
                }
        } else {
#pragma unroll
            for (int ai = 0; ai < 2; ++ai)
#pragma unroll
                for (int m = 0; m < 4; ++m) {
                    const int r = ai * 128 + wr * 64 + m * 16 + fr;
                    if (r < u.cnt) {
                        v4u w;
#pragma unroll
                        for (int bj = 0; bj < 2; ++bj)
#pragma unroll
                            for (int n = 0; n < 2; ++n) { const f32x4 v = acc[ai][bj][m][n] * (64.0f / (S_ACT * S_WD)); int p = 0;
                                p = __builtin_amdgcn_cvt_pk_fp8_f32(v[0], v[1], p, false); p = __builtin_amdgcn_cvt_pk_fp8_f32(v[2], v[3], p, true); w[2 * bj + n] = (unsigned)p; }
                        *(v4u*)(Y + (size_t)(u.y0 + r) * D + colb) = w;
                    }
                }
        }
    }
};

typedef float f32x16 __attribute__((ext_vector_type(16)));
constexpr int VT_STRIDE = 392;
constexpr int HROW = 1028;
__device__ __forceinline__ void attn_unit(Frame& F, int t0) {
    LAS unsigned char* Kl = F.lds; LAS unsigned char* Vt = F.lds + 49152; LAS float* red = (LAS float*)(F.lds + 49152 + 2 * 64 * VT_STRIDE);
    const bf16* Qb = (const bf16*)(F.ws + WS_A2 + U_Q); const bf16* Kb = (const bf16*)(F.ws + WS_A2 + U_K); const bf16* Vb = (const bf16*)(F.ws + WS_A2 + U_V);
    bf16* MIX = (bf16*)(F.ws + WS_A1);
    bf16x8 qf[2][4]; f32x4 gav[2][4];
    { const int h = F.wave, r = F.lane & 31, hh = F.lane >> 5;
#pragma unroll
      for (int qb = 0; qb < 2; ++qb) { const bf16* qp = Qb + (size_t)(t0 + 32 * qb + r) * AW + h * 64 + 8 * hh;
#pragma unroll
          for (int ds = 0; ds < 4; ++ds) qf[qb][ds] = *(const bf16x8*)(qp + 16 * ds); }
#pragma unroll
      for (int dt = 0; dt < 2; ++dt)
#pragma unroll
          for (int g = 0; g < 4; ++g) gav[dt][g] = *(const f32x4*)(F.in[I_GATTN] + h * 64 + 32 * dt + 8 * g + 4 * hh); }
    const float sink2 = F.in[I_SINKS][F.wave] * LOG2E;
    for (int p = F.tid; p < 3072; p += 512) {
        const int kv = p / 1536, r = (p % 1536) / 8, ch = p % 8, kj = t0 - 128 + r;
        v4u kval = (v4u){0u, 0u, 0u, 0u}, vval = (v4u){0u, 0u, 0u, 0u};
        if (kj >= 0) { kval = *(const v4u*)(Kb + (size_t)kj * KVW + kv * 64 + ch * 8); vval = *(const v4u*)(Vb + (size_t)kj * KVW + kv * 64 + ch * 8); }
        *(LAS v4u*)(Kl + (kv * 192 + r) * 128 + ((ch ^ (r & 7)) << 4)) = kval;
        LAS unsigned short* vcol = (LAS unsigned short*)(Vt + (kv * 64 + ch * 8) * VT_STRIDE + r * 2);
#pragma unroll
        for (int i = 0; i < 4; ++i) { vcol[(2 * i) * (VT_STRIDE / 2)] = (unsigned short)(vval[i] & 0xffffu); vcol[(2 * i + 1) * (VT_STRIDE / 2)] = (unsigned short)(vval[i] >> 16); }
    }
    __syncthreads();
    const int h = F.wave, kv = h >> 2, r = F.lane & 31, hh = F.lane >> 5;
    f32x16 O[2][2];
    float ssq[2];
#pragma unroll
    for (int qb = 0; qb < 2; ++qb) {
        f32x16 Sx[5];
#pragma unroll
        for (int i = 0; i < 5; ++i) {
            const int kt = qb + i;
#pragma unroll
            for (int e = 0; e < 16; ++e) Sx[i][e] = 0.f;
#pragma unroll
            for (int ds = 0; ds < 4; ++ds) {
                const bf16x8 a = *(const LAS bf16x8*)(Kl + (kv * 192 + 32 * kt + r) * 128 + (((2 * ds + hh) ^ (r & 7)) << 4));
                Sx[i] = __builtin_amdgcn_mfma_f32_32x32x16_bf16(a, qf[qb][ds], Sx[i], 0, 0, 0);
            }
        }
        const int q = 32 * qb + r;
        float mx = sink2;
#pragma unroll
        for (int i = 0; i < 5; ++i)
#pragma unroll
            for (int e = 0; e < 16; ++e) {
                const int j = 32 * (qb + i) + (e & 3) + 8 * (e >> 2) + 4 * hh;
                const bool valid = (j >= q + 1) && (j <= q + 128) && (t0 - 128 + j >= 0);
                const float v = valid ? Sx[i][e] : -1e30f; Sx[i][e] = v; mx = fmaxf(mx, v);
            }
        mx = fmaxf(mx, __shfl_xor(mx, 32));
        float l = 0.f;
#pragma unroll
        for (int i = 0; i < 5; ++i)
#pragma unroll
            for (int e = 0; e < 16; ++e) { const float pv = __builtin_amdgcn_exp2f(Sx[i][e] - mx); Sx[i][e] = pv; l += pv; }
        l += __shfl_xor(l, 32);
        l += __builtin_amdgcn_exp2f(sink2 - mx);
        const float inv = __builtin_amdgcn_rcpf(l);
#pragma unroll
        for (int dt = 0; dt < 2; ++dt)
#pragma unroll
            for (int e = 0; e < 16; ++e) O[qb][dt][e] = 0.f;
#pragma unroll
        for (int i = 0; i < 5; ++i) {
            const int kt = qb + i;
#pragma unroll
            for (int sI = 0; sI < 2; ++sI) {
                bf16x8 pb;
                { unsigned w0 = pg8::cvt_pk_bf16(Sx[i][8 * sI + 0] * inv, Sx[i][8 * sI + 1] * inv), w1 = pg8::cvt_pk_bf16(Sx[i][8 * sI + 2] * inv, Sx[i][8 * sI + 3] * inv),
                           w2 = pg8::cvt_pk_bf16(Sx[i][8 * sI + 4] * inv, Sx[i][8 * sI + 5] * inv), w3 = pg8::cvt_pk_bf16(Sx[i][8 * sI + 6] * inv, Sx[i][8 * sI + 7] * inv);
                  v4u pw = (v4u){w0, w1, w2, w3}; pb = __builtin_bit_cast(bf16x8, pw); }
                const int key0 = 32 * kt + 16 * sI + 4 * hh;
#pragma unroll
                for (int dt = 0; dt < 2; ++dt) {
                    const LAS unsigned char* vp = Vt + (kv * 64 + 32 * dt + r) * VT_STRIDE + key0 * 2;
                    const v2u lo = *(const LAS v2u*)vp, hi = *(const LAS v2u*)(vp + 16);
                    const v4u av = (v4u){lo.x, lo.y, hi.x, hi.y};
                    O[qb][dt] = __builtin_amdgcn_mfma_f32_32x32x16_bf16(__builtin_bit_cast(bf16x8, av), pb, O[qb][dt], 0, 0, 0);
                }
            }
        }
        float sq = 0.f;
#pragma unroll
        for (int dt = 0; dt < 2; ++dt)
#pragma unroll
            for (int e = 0; e < 16; ++e) sq += O[qb][dt][e] * O[qb][dt][e];
        sq += __shfl_xor(sq, 32);
        ssq[qb] = sq;
        if (hh == 0) red[h * 64 + q] = sq;
    }
    __syncthreads();
#pragma unroll
    for (int qb = 0; qb < 2; ++qb) {
        const int q = 32 * qb + r;
        float tot = 0.f;
#pragma unroll
        for (int w = 0; w < 8; ++w) tot += red[w * 64 + q];
        const float rsn = 1.0f / sqrtf(tot * (1.0f / AW) + NORM_EPS);
        bf16* orow = MIX + (size_t)(t0 + q) * D + h * 64;
#pragma unroll
        for (int dt = 0; dt < 2; ++dt)
#pragma unroll
            for (int g = 0; g < 4; ++g) {
                const int d = 32 * dt + 8 * g + 4 * hh;
                const f32x4 gg = gav[dt][g];
                v2u w; w.x = pk2(O[qb][dt][4 * g + 0] * rsn * gg[0], O[qb][dt][4 * g + 1] * rsn * gg[1]); w.y = pk2(O[qb][dt][4 * g + 2] * rsn * gg[2], O[qb][dt][4 * g + 3] * rsn * gg[3]);
                *(v2u*)(orow + d) = w;
            }
    }
    __syncthreads();
}
__device__ __forceinline__ float neg_expm1_small(float x) { return -x * (1.f + x * 0.5f * (1.f + x * (1.f / 3.f) * (1.f + x * 0.25f * (1.f + x * 0.2f * (1.f + x * (1.f / 6.f)))))); }
__device__ __forceinline__ float gelu_tanh(float x) { const float u = 0.7978845608028654f * (x + 0.044715f * x * x * x); const float e = fast_exp(2.0f * u); return x * (1.0f - __builtin_amdgcn_rcpf(e + 1.0f)); }
__device__ __forceinline__ float xor32(float x, int hh) {
    const unsigned u = __float_as_uint(x);
    const auto rr = __builtin_amdgcn_permlane32_swap(u, u, false, false);
    return __uint_as_float(hh ? rr[0] : rr[1]);
}
__device__ __forceinline__ void fold_granules(const unsigned long long* g0, size_t kstride, int k0, int k1, float& A0, float& B0, float& A1, float& B1, unsigned* tmo, int lane) {
    unsigned spins = 0; bool dead = false;
    for (int k = k0; k < k1; k += 4) {
        unsigned long long gv[4][4];
        for (;;) {
            bool ok = true;
#pragma unroll
            for (int i = 0; i < 4; ++i) { const int kk = (k + i < k1) ? k + i : k1 - 1;
                const unsigned long long* g = g0 + (size_t)kk * kstride;
                gv[i][0] = __hip_atomic_load(g, __ATOMIC_RELAXED, __HIP_MEMORY_SCOPE_AGENT); gv[i][1] = __hip_atomic_load(g + 1, __ATOMIC_RELAXED, __HIP_MEMORY_SCOPE_AGENT);
                gv[i][2] = __hip_atomic_load(g + 64, __ATOMIC_RELAXED, __HIP_MEMORY_SCOPE_AGENT); gv[i][3] = __hip_atomic_load(g + 65, __ATOMIC_RELAXED, __HIP_MEMORY_SCOPE_AGENT); }
#pragma unroll
            for (int i = 0; i < 4; ++i)
#pragma unroll
                for (int q = 0; q < 4; ++q) ok &= ((gv[i][q] >> 32) == 1ull);
            if (ok || dead) break;
            __builtin_amdgcn_s_sleep(2);
            if (++spins > (1u << 16)) { dead = true; if (lane == 0) atomicAdd(tmo, 1u); }
        }
#pragma unroll
        for (int i = 0; i < 4; ++i) if (k + i < k1) {
            const float p0 = __uint_as_float((unsigned)gv[i][0]), h0 = __uint_as_float((unsigned)gv[i][1]), p1 = __uint_as_float((unsigned)gv[i][2]), h1 = __uint_as_float((unsigned)gv[i][3]);
            A0 = p0 * A0; B0 = p0 * B0 + h0; A1 = p1 * A1; B1 = p1 * B1 + h1; }
    }
}
__device__ __forceinline__ void lru_unit(Frame& F, int chunk) {
    LAS unsigned char* xcl = F.lds;
    LAS float* ytile = (LAS float*)F.lds;
    const int t0 = chunk * 64, n = F.wave, r = F.lane & 31, hh = F.lane >> 5;
    const bf16* XR = (const bf16*)(F.ws + WS_A2 + U_XR); const bf16* YG = (const bf16*)(F.ws + WS_A2 + U_YG);
    bf16x8 bR[2][4], bI[2][4];
    { const bf16* gw = (const bf16*)(F.ws + WS_GW);
#pragma unroll
      for (int jt = 0; jt < 2; ++jt)
#pragma unroll
          for (int ks = 0; ks < 4; ++ks) { bR[jt][ks] = *(const bf16x8*)(gw + ((0 * 8 + n) * 64 + 32 * jt + r) * 64 + 16 * ks + 8 * hh); bI[jt][ks] = *(const bf16x8*)(gw + ((1 * 8 + n) * 64 + 32 * jt + r) * 64 + 16 * ks + 8 * hh); } }
    float brg_[2], big_[2], lam_[2];
#pragma unroll
    for (int jt = 0; jt < 2; ++jt) { const int c = n * 64 + 32 * jt + r; brg_[jt] = F.in[I_BRG][c]; big_[jt] = F.in[I_BIG][c]; lam_[jt] = F.in[I_LAM][c]; }
    {
        const int c = n * 64 + F.lane;
        const float* cw = F.in[I_CONVW]; const float w0 = cw[c], w1 = cw[LW + c], w2 = cw[2 * LW + c], w3 = cw[3 * LW + c], cb = F.in[I_CONVB][c];
        LAS unsigned char* raw = F.lds + 65536;
        for (int p = F.tid; p < 67 * 64; p += 512) { const int row = p >> 6, ch = p & 63, tr = t0 - 3 + row;
            v4u val = (v4u){0u, 0u, 0u, 0u};
            if (tr >= 0) val = *(const v4u*)(XR + (size_t)tr * LW + ch * 8);
            *(LAS v4u*)(raw + row * 1024 + ch * 16) = val; }
        __syncthreads();
        const LAS unsigned short* rc_ = (const LAS unsigned short*)raw + c;
        float x0 = bf2f(rc_[0]), x1 = bf2f(rc_[512]), x2 = bf2f(rc_[1024]);
        LAS unsigned char* dst = xcl + n * 8192 + (F.lane & 7) * 2;
#pragma unroll 16
        for (int tl = 0; tl < 64; ++tl) { const float x3 = bf2f(rc_[(tl + 3) * 512]);
            *(LAS unsigned short*)(dst + tl * 128 + (((F.lane >> 3) ^ (tl & 7)) << 4)) = (unsigned short)f2bf(cb + w0 * x0 + w1 * x1 + w2 * x2 + w3 * x3); x0 = x1; x1 = x2; x2 = x3; }
    }
    __syncthreads();
    f32x16 aR[2][2], aI[2][2];
#pragma unroll
    for (int tt = 0; tt < 2; ++tt)
#pragma unroll
        for (int jt = 0; jt < 2; ++jt)
#pragma unroll
            for (int e = 0; e < 16; ++e) { aR[tt][jt][e] = 0.f; aI[tt][jt][e] = 0.f; }
#pragma unroll
    for (int tt = 0; tt < 2; ++tt)
#pragma unroll
        for (int ks = 0; ks < 4; ++ks) {
            const int t = 32 * tt + r;
            const bf16x8 a = *(const LAS bf16x8*)(xcl + n * 8192 + t * 128 + (((2 * ks + hh) ^ (t & 7)) << 4));
#pragma unroll
            for (int jt = 0; jt < 2; ++jt) { aR[tt][jt] = __builtin_amdgcn_mfma_f32_32x32x16_bf16(a, bR[jt][ks], aR[tt][jt], 0, 0, 0); aI[tt][jt] = __builtin_amdgcn_mfma_f32_32x32x16_bf16(a, bI[jt][ks], aI[tt][jt], 0, 0, 0); }
        }
#pragma unroll
    for (int jt = 0; jt < 2; ++jt) {
        const int cl_ = 32 * jt + r;
        const float brg = brg_[jt], big = big_[jt]; const float sp8 = -8.0f * log1pf(expf(-lam_[jt]));
#pragma unroll
        for (int tt = 0; tt < 2; ++tt)
#pragma unroll
            for (int e = 0; e < 16; ++e) {
                const int t = 32 * tt + (e & 3) + 8 * (e >> 2) + 4 * hh;
                const float xcv = bf2f(*(const LAS unsigned short*)(xcl + n * 8192 + t * 128 + (((cl_ >> 3) ^ (t & 7)) << 4) + (cl_ & 7) * 2));
                const float rg = sigmoidf_(aR[tt][jt][e] + brg), ig = sigmoidf_(aI[tt][jt][e] + big);
                const float la = rg * sp8; const float a = fast_exp(la);
                aR[tt][jt][e] = a; aI[tt][jt][e] = __builtin_amdgcn_sqrtf(neg_expm1_small(2.0f * la)) * (ig * xcv);
            }
    }
#pragma unroll
    for (int tt = 0; tt < 2; ++tt)
#pragma unroll
        for (int jt = 0; jt < 2; ++jt)
#pragma unroll
            for (int g = 0; g < 4; ++g)
#pragma unroll
                for (int x = 1; x < 4; ++x) { aI[tt][jt][4 * g + x] = aR[tt][jt][4 * g + x] * aI[tt][jt][4 * g + x - 1] + aI[tt][jt][4 * g + x]; aR[tt][jt][4 * g + x] *= aR[tt][jt][4 * g + x - 1]; }
    float hin[2][2][4], pin[2][2][4], Hend[2], Pend[2];
#pragma unroll
    for (int jt = 0; jt < 2; ++jt) {
        float Hs = 0.f, Ps = 1.f;
#pragma unroll
        for (int tt = 0; tt < 2; ++tt)
#pragma unroll
            for (int g = 0; g < 4; ++g) {
                const float PA = aR[tt][jt][4 * g + 3], HB = aI[tt][jt][4 * g + 3];
                const float He = PA * Hs + HB, Pe = PA * Ps;
                const float Hx = xor32(He, hh), Px = xor32(Pe, hh);
                const float hi_ = hh ? Hx : Hs, pi_ = hh ? Px : Ps;
                hin[jt][tt][g] = hi_; pin[jt][tt][g] = pi_;
                const float Ho = PA * hi_ + HB, Po = PA * pi_;
                Hs = xor32(Ho, hh); Ps = xor32(Po, hh);
                if (tt == 1 && g == 3) { Hend[jt] = Ho; Pend[jt] = Po; }
            }
    }
    unsigned long long* agg = (unsigned long long*)(F.ws + WS_AGG);
    if (hh == 1) {
#pragma unroll
        for (int jt = 0; jt < 2; ++jt) { unsigned long long* g = agg + ((size_t)chunk * LW + n * 64 + 32 * jt + r) * 2;
            __hip_atomic_store(g, (1ull << 32) | (unsigned long long)__float_as_uint(Pend[jt]), __ATOMIC_RELAXED, __HIP_MEMORY_SCOPE_AGENT);
            __hip_atomic_store(g + 1, (1ull << 32) | (unsigned long long)__float_as_uint(Hend[jt]), __ATOMIC_RELAXED, __HIP_MEMORY_SCOPE_AGENT); }
    }
    __syncthreads();
    float C[2];
    {
        const unsigned long long* l1 = agg + ((size_t)n * 64 + r) * 2;
        unsigned long long* l2w = agg + (size_t)256 * LW * 2;
        const unsigned long long* l2 = l2w + ((size_t)n * 64 + r) * 2;
        const int grp = chunk >> 4, pos = chunk & 15, kb = grp * 16;
        float A0 = 1.f, B0 = 0.f, A1 = 1.f, B1 = 0.f;
        { const int mid = kb + (pos >> 1); fold_granules(l1, (size_t)LW * 2, hh ? mid : kb, hh ? chunk : mid, A0, B0, A1, B1, F.ctl + CW_TMO2, F.lane); }
        float GA0, GB0, GA1, GB1;
        { const float oa0 = xor32(A0, hh), ob0 = xor32(B0, hh), oa1 = xor32(A1, hh), ob1 = xor32(B1, hh);
          const float fa0 = hh ? oa0 : A0, fb0 = hh ? ob0 : B0, sa0 = hh ? A0 : oa0, sb0 = hh ? B0 : ob0;
          const float fa1 = hh ? oa1 : A1, fb1 = hh ? ob1 : B1, sa1 = hh ? A1 : oa1, sb1 = hh ? B1 : ob1;
          GA0 = sa0 * fa0; GB0 = sa0 * fb0 + sb0; GA1 = sa1 * fa1; GB1 = sa1 * fb1 + sb1; }
        if (pos == 15 && hh == 1) {
            unsigned long long* g = l2w + ((size_t)grp * LW + n * 64 + r) * 2;
            __hip_atomic_store(g, (1ull << 32) | (unsigned long long)__float_as_uint(Pend[0] * GA0), __ATOMIC_RELAXED, __HIP_MEMORY_SCOPE_AGENT);
            __hip_atomic_store(g + 1, (1ull << 32) | (unsigned long long)__float_as_uint(Pend[0] * GB0 + Hend[0]), __ATOMIC_RELAXED, __HIP_MEMORY_SCOPE_AGENT);
            __hip_atomic_store(g + 64, (1ull << 32) | (unsigned long long)__float_as_uint(Pend[1] * GA1), __ATOMIC_RELAXED, __HIP_MEMORY_SCOPE_AGENT);
            __hip_atomic_store(g + 65, (1ull << 32) | (unsigned long long)__float_as_uint(Pend[1] * GB1 + Hend[1]), __ATOMIC_RELAXED, __HIP_MEMORY_SCOPE_AGENT);
        }
        float LA0 = 1.f, LB0 = 0.f, LA1 = 1.f, LB1 = 0.f;
        { const int mid = grp >> 1; fold_granules(l2, (size_t)LW * 2, hh ? mid : 0, hh ? grp : mid, LA0, LB0, LA1, LB1, F.ctl + CW_TMO2, F.lane); }
        float c0, c1;
        { const float ob0 = xor32(LB0, hh), oa0 = xor32(LA0, hh), ob1 = xor32(LB1, hh), oa1 = xor32(LA1, hh);
          const float fb0 = hh ? ob0 : LB0, sa0 = hh ? LA0 : oa0, sb0 = hh ? LB0 : ob0, fb1 = hh ? ob1 : LB1, sa1 = hh ? LA1 : oa1, sb1 = hh ? LB1 : ob1;
          c0 = sa0 * fb0 + sb0; c1 = sa1 * fb1 + sb1; }
        C[0] = GA0 * c0 + GB0; C[1] = GA1 * c1 + GB1;
    }
#pragma unroll
    for (int jt = 0; jt < 2; ++jt) {
        const int c = n * 64 + 32 * jt + r;
#pragma unroll
        for (int tt = 0; tt < 2; ++tt)
#pragma unroll
            for (int g = 0; g < 4; ++g) {
                const float base = hin[jt][tt][g] + pin[jt][tt][g] * C[jt];
#pragma unroll
                for (int x = 0; x < 4; ++x) { const int e = 4 * g + x, t = 32 * tt + 8 * g + 4 * hh + x;
                    const float hv = aR[tt][jt][e] * base + aI[tt][jt][e];
                    ytile[t * 512 + c] = hv; }
            }
    }
    v4u ygv[8];
#pragma unroll
    for (int i = 0; i < 8; ++i) ygv[i] = *(const v4u*)(YG + (size_t)(t0 + 8 * F.wave + i) * LW + 8 * F.lane);
    __syncthreads();
    {
        const float* gl = F.in[I_GLRU] + 8 * F.lane; const f32x4 g0 = *(const f32x4*)gl, g1 = *(const f32x4*)(gl + 4);
        bf16* MIX = (bf16*)(F.ws + WS_A1);
#pragma unroll
        for (int i = 0; i < 8; ++i) { const int t = 8 * F.wave + i;
            f32x4 y0 = *(const LAS f32x4*)(ytile + t * 512 + 8 * F.lane), y1 = *(const LAS f32x4*)(ytile + t * 512 + 8 * F.lane + 4);
            { const v4u yg = ygv[i];
              y0[0] *= gelu_tanh(bf2f(yg[0] & 0xffffu)); y0[1] *= gelu_tanh(bf2f(yg[0] >> 16)); y0[2] *= gelu_tanh(bf2f(yg[1] & 0xffffu)); y0[3] *= gelu_tanh(bf2f(yg[1] >> 16));
              y1[0] *= gelu_tanh(bf2f(yg[2] & 0xffffu)); y1[1] *= gelu_tanh(bf2f(yg[2] >> 16)); y1[2] *= gelu_tanh(bf2f(yg[3] & 0xffffu)); y1[3] *= gelu_tanh(bf2f(yg[3] >> 16)); }
            const float sq = wave_sum((y0[0] * y0[0] + y0[1] * y0[1]) + (y0[2] * y0[2] + y0[3] * y0[3]) + (y1[0] * y1[0] + y1[1] * y1[1]) + (y1[2] * y1[2] + y1[3] * y1[3]));
            const float rsn = 1.0f / sqrtf(sq * (1.0f / LW) + NORM_EPS);
            v4u w; w.x = pk2(y0[0] * rsn * g0[0], y0[1] * rsn * g0[1]); w.y = pk2(y0[2] * rsn * g0[2], y0[3] * rsn * g0[3]); w.z = pk2(y1[0] * rsn * g1[0], y1[1] * rsn * g1[1]); w.w = pk2(y1[2] * rsn * g1[2], y1[3] * rsn * g1[3]);
            *(v4u*)(MIX + (size_t)(t0 + t) * D + AW + 8 * F.lane) = w; }
    }
    __syncthreads();
}
struct RtSel { bool chosen[4]; int rank[4]; float wgt[4]; unsigned li[4]; };
__device__ __forceinline__ void rt_load(Frame& F, int unit, f32x4 (&v)[4][4]) {
    const float* Z = (const float*)(F.ws + WS_A2); const float* X = F.in[I_X];
#pragma unroll
    for (int rr = 0; rr < 4; ++rr) { const f32x4* zr = (const f32x4*)(Z + (size_t)(unit * 32 + F.wave * 4 + rr) * D) + F.lane;
#pragma unroll
        for (int j = 0; j < 4; ++j) v[rr][j] = zr[64 * j]; }
#pragma unroll
    for (int rr = 0; rr < 4; ++rr) { const f32x4* xr = (const f32x4*)(X + (size_t)(unit * 32 + F.wave * 4 + rr) * D) + F.lane;
#pragma unroll
        for (int j = 0; j < 4; ++j) v[rr][j] = v[rr][j] + xr[64 * j] * ALPHA; }
}
__device__ __forceinline__ void rt_norm(Frame& F, int unit, f32x4 (&v)[4][4], LAS float* hrow) {
    unsigned char* H8 = F.ws + WS_A1;
    const float* g1 = F.in[I_LN1G]; const float* b1 = F.in[I_LN1B];
    float mean[4], rstd[4];
#pragma unroll
    for (int rr = 0; rr < 4; ++rr) { float s = 0.f;
#pragma unroll
        for (int j = 0; j < 4; ++j) s += (v[rr][j].x + v[rr][j].y) + (v[rr][j].z + v[rr][j].w);
        mean[rr] = s; }
#pragma unroll
    for (int o = 1; o < 64; o <<= 1) {
#pragma unroll
        for (int rr = 0; rr < 4; ++rr) mean[rr] += __shfl_xor(mean[rr], o); }
#pragma unroll
    for (int rr = 0; rr < 4; ++rr) { mean[rr] *= (1.f / D); float s2 = 0.f;
#pragma unroll
        for (int j = 0; j < 4; ++j) { v[rr][j] = v[rr][j] - mean[rr]; s2 += (v[rr][j].x * v[rr][j].x + v[rr][j].y * v[rr][j].y) + (v[rr][j].z * v[rr][j].z + v[rr][j].w * v[rr][j].w); }
        rstd[rr] = s2; }
#pragma unroll
    for (int o = 1; o < 64; o <<= 1) {
#pragma unroll
        for (int rr = 0; rr < 4; ++rr) rstd[rr] += __shfl_xor(rstd[rr], o); }
#pragma unroll
    for (int j = 0; j < 4; ++j) {
        const f32x4 gg = *((const f32x4*)g1 + F.lane + 64 * j), bb = *((const f32x4*)b1 + F.lane + 64 * j);
#pragma unroll
        for (int rr = 0; rr < 4; ++rr) {
            const int tl = F.wave * 4 + rr; const size_t row = (size_t)(unit * 32 + tl);
            const float rs = 1.f / sqrtf(rstd[rr] * (1.f / D) + NORM_EPS);
            const f32x4 hv = v[rr][j] * rs * gg + bb;
            *((LAS f32x4*)(hrow + tl * HROW) + F.lane + 64 * j) = hv;
            *((f32x4*)(F.out + row * D) + F.lane + 64 * j) = hv * ALPHA;
            { int p = 0; p = __builtin_amdgcn_cvt_pk_fp8_f32(hv.x * S_H8, hv.y * S_H8, p, false); p = __builtin_amdgcn_cvt_pk_fp8_f32(hv.z * S_H8, hv.w * S_H8, p, true); *((unsigned*)(H8 + row * D) + F.lane + 64 * j) = (unsigned)p; }
        }
    }
}
__device__ __forceinline__ void rt_logits(Frame& F, LAS float* hrow, LAS float* lg) {
    const int r = F.lane & 31, hh = F.lane >> 5;
    const bf16* wrh = (const bf16*)(F.ws + WS_WRH); const bf16* wrl = (const bf16*)(F.ws + WS_WRL);
    f32x16 acc[2];
#pragma unroll
    for (int e = 0; e < 16; ++e) { acc[0][e] = 0.f; acc[1][e] = 0.f; }
#pragma unroll 4
    for (int ksl = 0; ksl < 8; ++ksl) {
        const int k0 = 128 * F.wave + 16 * ksl + 8 * hh;
        const f32x4 x0 = *(const LAS f32x4*)(hrow + r * HROW + k0), x1 = *(const LAS f32x4*)(hrow + r * HROW + k0 + 4);
        v4u ah, al;
#pragma unroll
        for (int q = 0; q < 2; ++q) {
            const f32x4 xv = q ? x1 : x0;
            const unsigned h01 = pg8::cvt_pk_bf16(xv[0], xv[1]), h23 = pg8::cvt_pk_bf16(xv[2], xv[3]);
            const unsigned l01 = pg8::cvt_pk_bf16(xv[0] - bf2f(h01 & 0xffffu), xv[1] - bf2f(h01 >> 16)), l23 = pg8::cvt_pk_bf16(xv[2] - bf2f(h23 & 0xffffu), xv[3] - bf2f(h23 >> 16));
            ah[2 * q] = h01; ah[2 * q + 1] = h23; al[2 * q] = l01; al[2 * q + 1] = l23;
        }
        const bf16x8 ahi = __builtin_bit_cast(bf16x8, ah), alo = __builtin_bit_cast(bf16x8, al);
#pragma unroll
        for (int nt = 0; nt < 2; ++nt) {
            const bf16x8 bh = *(const bf16x8*)(wrh + (size_t)(32 * nt + r) * D + k0), bl = *(const bf16x8*)(wrl + (size_t)(32 * nt + r) * D + k0);
            acc[nt] = __builtin_amdgcn_mfma_f32_32x32x16_bf16(ahi, bh, acc[nt], 0, 0, 0);
            acc[nt] = __builtin_amdgcn_mfma_f32_32x32x16_bf16(ahi, bl, acc[nt], 0, 0, 0);
            acc[nt] = __builtin_amdgcn_mfma_f32_32x32x16_bf16(alo, bh, acc[nt], 0, 0, 0);
        }
    }
    __syncthreads();
    LAS float* part = hrow;
#pragma unroll
    for (int nt = 0; nt < 2; ++nt)
#pragma unroll
        for (int e = 0; e < 16; ++e) part[(F.wave * 32 + (e & 3) + 8 * (e >> 2) + 4 * hh) * 64 + 32 * nt + r] = acc[nt][e];
    __syncthreads();
#pragma unroll
    for (int i = 0; i < 4; ++i) { const int idx = F.tid + 512 * i;
        float a = 0.f;
#pragma unroll
        for (int w = 0; w < 8; ++w) a += part[w * 2048 + idx];
        lg[idx] = a; }
    __syncthreads();
}
__device__ __forceinline__ void rt_topk(Frame& F, const LAS float* lg, LAS unsigned* lc, RtSel& R) {
    const int e = F.lane, grp = e >> 3;
    const float eb = F.in[I_EBIAS][e];
#pragma unroll
    for (int q = 0; q < 4; ++q) {
        const int tl = F.wave * 4 + q;
        const float score = sigmoidf_(lg[tl * 64 + e]); const float sel = score + eb;
        float m1 = sel;
        m1 = fmaxf(m1, __shfl_xor(m1, 1)); m1 = fmaxf(m1, __shfl_xor(m1, 2)); m1 = fmaxf(m1, __shfl_xor(m1, 4));
        const unsigned long long bm = __ballot(sel == m1);
        const unsigned gb = (unsigned)(bm >> (8 * grp)) & 0xffu; const int first = __builtin_ctz(gb | 0x100u);
        float m2 = ((e & 7) == first) ? -INFINITY : sel;
        m2 = fmaxf(m2, __shfl_xor(m2, 1)); m2 = fmaxf(m2, __shfl_xor(m2, 2)); m2 = fmaxf(m2, __shfl_xor(m2, 4));
        const float gs = m1 + m2;
        int grank = 0;
#pragma unroll
        for (int g2 = 0; g2 < 8; ++g2) { const float o = __int_as_float(__builtin_amdgcn_readlane(__float_as_int(gs), 8 * g2)); grank += (o > gs || (o == gs && g2 < grp)) ? 1 : 0; }
        const float sm = grank < 4 ? sel : -INFINITY;
        int rank = 0;
#pragma unroll
        for (int e2 = 0; e2 < 64; ++e2) { const float o = __int_as_float(__builtin_amdgcn_readlane(__float_as_int(sm), e2)); rank += (o > sm || (o == sm && e2 < e)) ? 1 : 0; }
        const bool chosen = (grank < 4) && (rank < 8);
        const float wsum = wave_sum(chosen ? score : 0.f);
        R.chosen[q] = chosen; R.rank[q] = rank; R.wgt[q] = score * (2.5f / wsum);
        R.li[q] = chosen ? __hip_atomic_fetch_add(lc + e, 1u, __ATOMIC_RELAXED, __HIP_MEMORY_SCOPE_WORKGROUP) : 0u;
    }
}
__device__ __forceinline__ void rt_emit(Frame& F, int unit, const LAS unsigned* gb, const RtSel& R) {
    int* tok = (int*)(F.ws + WS_TOK); const int e = F.lane;
    const unsigned base = gb[e];
#pragma unroll
    for (int q = 0; q < 4; ++q) if (R.chosen[q]) { const int t = unit * 32 + F.wave * 4 + q; const unsigned slot = base + R.li[q];
        tok[e * LCAP + slot] = t;
        ((int*)(F.ws + WS_RIE))[(size_t)t * 8 + R.rank[q]] = e | (int)(slot << 8);
        ((float*)(F.ws + WS_RIW))[(size_t)t * 8 + R.rank[q]] = R.wgt[q]; }
}
__device__ __forceinline__ void route_phase(Frame& F) {
    LAS float* hrow = (LAS float*)F.lds;
    LAS float* lg = (LAS float*)(F.lds + SCR_OFF + 512);
    LAS unsigned* lc = (LAS unsigned*)(F.lds + SCR_OFF + 512 + 8192);
    LAS unsigned* gb = lc + 64;
    const int u0 = F.vcu, u1 = F.vcu + F.G;
    const bool has0 = u0 < S / 32, has1 = u1 < S / 32;
    if (!has0) return;
    if (F.tid < 64) lc[F.tid] = 0u;
    f32x4 v[4][4];
    RtSel R0, R1;
    rt_load(F, u0, v);
    rt_norm(F, u0, v, hrow);
    if (has1) rt_load(F, u1, v);
    __syncthreads();
    rt_logits(F, hrow, lg);
    rt_topk(F, lg, lc, R0);
    if (has1) {
        __syncthreads();
        rt_norm(F, u1, v, hrow);
        __syncthreads();
        rt_logits(F, hrow, lg);
        rt_topk(F, lg, lc, R1);
    }
    __syncthreads();
    if (F.tid < 64) { const unsigned c = lc[F.tid]; gb[F.tid] = c ? atomicAdd(F.ctl + CW_CNT + 16 * F.tid, c) : 0u; }
    __syncthreads();
    rt_emit(F, u0, gb, R0);
    if (has1) rt_emit(F, u1, gb, R1);
}
struct CombRow { v4u y[8]; float w[8]; };
__device__ __forceinline__ void comb_load(Frame& F, const LAS int* rb, int ek, float wk, CombRow& R) {
    const unsigned char* Y = F.ws + WS_Y8;
#pragma unroll
    for (int k = 0; k < 8; ++k) {
        const int ee = __builtin_amdgcn_readlane(ek, k); R.w[k] = __int_as_float(__builtin_amdgcn_readlane(__float_as_int(wk), k));
        const int row = rb[ee & 255] + (ee >> 8);
        R.y[k] = *(const v4u*)(Y + (size_t)row * D + F.lane * 16);
    }
}
__device__ __forceinline__ void comb_finish(Frame& F, int m, CombRow& R) {
    f32x4* xo = (f32x4*)(F.out + (size_t)m * D) + F.lane * 4;
    f32x4 v[4], a4[4];
#pragma unroll
    for (int j = 0; j < 4; ++j) { v[j] = xo[j]; a4[j] = (f32x4){0.f, 0.f, 0.f, 0.f}; }
#pragma unroll
    for (int k = 0; k < 8; ++k) { const float ww = R.w[k];
#pragma unroll
        for (int j = 0; j < 4; ++j) { const f32x2 a = __builtin_amdgcn_cvt_pk_f32_fp8((int)R.y[k][j], false), b = __builtin_amdgcn_cvt_pk_f32_fp8((int)R.y[k][j], true);
            a4[j].x += ww * a.x; a4[j].y += ww * a.y; a4[j].z += ww * b.x; a4[j].w += ww * b.y; } }
    float s = 0.f;
#pragma unroll
    for (int j = 0; j < 4; ++j) { v[j] = v[j] + a4[j]; s += (v[j].x + v[j].y) + (v[j].z + v[j].w); }
    const float mean = wave_sum(s) * (1.f / D); float s2 = 0.f;
#pragma unroll
    for (int j = 0; j < 4; ++j) { v[j] = v[j] - mean; s2 += (v[j].x * v[j].x + v[j].y * v[j].y) + (v[j].z * v[j].z + v[j].w * v[j].w); }
    const float rstd = 1.f / sqrtf(wave_sum(s2) * (1.f / D) + NORM_EPS);
#pragma unroll
    for (int j = 0; j < 4; ++j) { const f32x4 gg = *((const f32x4*)F.in[I_LN2G] + F.lane * 4 + j), bb = *((const f32x4*)F.in[I_LN2B] + F.lane * 4 + j); xo[j] = v[j] * rstd * gg + bb; }
}
__device__ __forceinline__ void combine_rows(Frame& F, const LAS int* rb) {
    const int gw = F.vcu * NWAVES + F.wave, NGW = F.G * NWAVES;
    const int* rie = (const int*)(F.ws + WS_RIE); const float* riw = (const float*)(F.ws + WS_RIW);
    const int nrows = (S - gw + NGW - 1) / NGW;
    if (nrows <= 0) return;
    const int l8 = F.lane & 7;
    int ek1 = rie[(size_t)gw * 8 + l8]; float wk1 = riw[(size_t)gw * 8 + l8] * (1.0f / 64.0f);
    int ek2 = 0; float wk2 = 0.f;
    if (nrows > 1) { ek2 = rie[(size_t)(gw + NGW) * 8 + l8]; wk2 = riw[(size_t)(gw + NGW) * 8 + l8] * (1.0f / 64.0f); }
    CombRow RA, RB;
    comb_load(F, rb, ek1, wk1, RA);
#pragma unroll 1
    for (int i = 0; i < nrows; i += 2) {
        int ek3 = 0; float wk3 = 0.f;
        if (i + 2 < nrows) { const size_t m = (size_t)(gw + (i + 2) * NGW); ek3 = rie[m * 8 + l8]; wk3 = riw[m * 8 + l8] * (1.0f / 64.0f); }
        if (i + 1 < nrows) comb_load(F, rb, ek2, wk2, RB);
        comb_finish(F, gw + i * NGW, RA);
        int ek4 = 0; float wk4 = 0.f;
        if (i + 3 < nrows) { const size_t m = (size_t)(gw + (i + 3) * NGW); ek4 = rie[m * 8 + l8]; wk4 = riw[m * 8 + l8] * (1.0f / 64.0f); }
        if (i + 2 < nrows) comb_load(F, rb, ek3, wk3, RA);
        if (i + 1 < nrows) comb_finish(F, gw + (i + 1) * NGW, RB);
        ek2 = ek4; wk2 = wk4;
    }
}
__device__ __forceinline__ void moe_table(Frame& F, LAS int* tb, LAS int* cl, LAS int* rb) {
    if (F.tid == 0) { int acc = 0, racc = 0; for (int e = 0; e < NEX; ++e) { const int c = (int)F.ctl[CW_CNT + 16 * e]; cl[e] = c; tb[e] = acc; rb[e] = racc; acc += (c + 255) >> 8; racc += c; } tb[NEX] = acc; rb[NEX] = racc; }
    __syncthreads();
}

struct Args { const float* in[25]; float* out; unsigned char* ws; int ph_lo, ph_hi, li, pad; };
__global__ void __launch_bounds__(NWAVES * 64, 2) fwd(Args args) {
    extern __shared__ __attribute__((aligned(16))) unsigned char lds[];
    Frame F;
    F.lds = (LAS unsigned char*)lds;
    F.MISC = (volatile LAS unsigned*)(F.lds + MISC_OFF);
    F.tid = threadIdx.x; F.lane = F.tid & 63; F.wave = __builtin_amdgcn_readfirstlane(F.tid >> 6);
    F.G = gridDim.x; { const int bx = blockIdx.x; F.vcu = (F.G % 8 == 0) ? (bx % 8) * (F.G / 8) + bx / 8 : bx; }
    F.ws = args.ws; F.out = args.out; F.ctl = (unsigned*)(args.ws + WS_CTL);
#pragma unroll
    for (int i = 0; i < 25; ++i) F.in[i] = args.in[i];
    for (int u = F.tid; u < 128; u += NWAVES * 64) ((LAS unsigned*)(F.lds + MISC_OFF))[u] = 0u;
    __syncthreads();
    XcdBarrier bar; bar.bar = F.ctl + CW_BAR; bar.x = 0; bar.st = nullptr;
    if (MK_N_LAUNCHES == 1) bar = xcd_barrier_post(F.ctl + CW_BAR, F.MISC + 8);
    const int lo = args.ph_lo, hi = args.ph_hi;
#ifndef PH_MASK
#define PH_MASK 0x1ff
#endif
#define IN(k) (((PH_MASK >> (k)) & 1) && lo <= (k) && (k) < hi)
#define BOTH(k) (IN(k) && IN((k) + 1))
#ifndef PH_REP
#define PH_REP 0
#endif
#define REPS(k) for (int _rep = 0; _rep < 1 + ((PH_REP >> (k)) & 1); ++_rep)
#define GRID_BAR() do { if (MK_N_LAUNCHES == 1) xcd_barrier(bar); } while (0)

    if (IN(0)) REPS(0) { p0_prologue(F); if (BOTH(0)) GRID_BAR(); }
    if (IN(1)) REPS(1) {
        DenseOrder So; So.init(S, NIN, D, F.ws + WS_WIN, F.G, (int)blockIdx.x);
        EpiInProj E{(bf16*)(F.ws + WS_A2 + U_Q), (bf16*)(F.ws + WS_A2 + U_K), (bf16*)(F.ws + WS_A2 + U_V), (bf16*)(F.ws + WS_A2 + U_XR), (bf16*)(F.ws + WS_A2 + U_YG), (const float*)(F.ws + WS_ROPEC), (const float*)(F.ws + WS_ROPES)};
        pg8::gemm_phase<EpiInProj, DenseOrder, true>(F.lds, (const char*)(F.ws + WS_A1), D, So, E);
        if (BOTH(1)) GRID_BAR();
    }
    if (IN(2)) REPS(2) {
        { const int u = F.vcu; if (u < S / 64) { lru_unit(F, u); attn_unit(F, u * 64); } }
        if (BOTH(2)) GRID_BAR();
    }
    if (IN(4)) REPS(4) {
        DenseOrder So; So.init(S, D, D, F.ws + WS_WOUT, F.G, (int)blockIdx.x);
        EpiZ E{(float*)(F.ws + WS_A2)};
        pg8::gemm_phase<EpiZ, DenseOrder, true>(F.lds, (const char*)(F.ws + WS_A1), D, So, E);
        if (BOTH(4)) GRID_BAR();
    }
    if (IN(5)) REPS(5) {
        route_phase(F);
        if (BOTH(5)) GRID_BAR();
    }
    if (IN(6)) REPS(6) {
        LAS int* tb = (LAS int*)(F.lds + SCR_OFF); LAS int* cl = tb + 128; LAS int* rb = tb + 256;
        moe_table(F, tb, cl, rb);
        LAS int* ut = tb + 384;
        MoeOrder So{tb, cl, rb, (const int*)(F.ws + WS_TOK), (const char*)(F.ws + WS_WGU), (size_t)512 * D, (size_t)256 * D, 2, F.G, F.vcu, tb[NEX] * 2, D, true, ut};
        So.build(ut, F.tid); __syncthreads();
        EpiAct E{F.ws + WS_A2};
        pg8::gemm_phase<EpiAct, MoeOrder, true, true>(F.lds, (const char*)(F.ws + WS_A1), D / 2, So, E);
        if (BOTH(6)) GRID_BAR();
    }
    if (IN(7)) REPS(7) {
        LAS int* tb = (LAS int*)(F.lds + SCR_OFF); LAS int* cl = tb + 128; LAS int* rb = tb + 256;
        moe_table(F, tb, cl, rb);
        LAS int* ut = tb + 384;
        MoeOrder So{tb, cl, rb, (const int*)(F.ws + WS_TOK), (const char*)(F.ws + WS_WD), (size_t)D * DE, (size_t)256 * DE, 4, F.G, F.vcu, tb[NEX] * 4, DE, false, ut};
        So.build(ut, F.tid); __syncthreads();
        EpiY8 E{F.ws + WS_Y8, F.out, (PROBE_PHASE >= 0 && args.li == 1) ? 1 : 0};
        pg8::gemm_phase<EpiY8, MoeOrder, true, true>(F.lds, (const char*)(F.ws + WS_A2), DE / 2, So, E);
        if (BOTH(7)) GRID_BAR();
    }
    if (IN(8)) REPS(8) {
        LAS int* tb = (LAS int*)(F.lds + SCR_OFF); LAS int* cl = tb + 128; LAS int* rb = tb + 256;
        moe_table(F, tb, cl, rb);
        combine_rows(F, rb);
    }
#undef IN
#undef BOTH
#undef GRID_BAR
}

extern "C" void kernel_launch(void* const* d_in, const int* in_sizes, int n_in, void* d_out, int out_size, void* d_ws, size_t ws_size, hipStream_t stream) {
    static int grid = 0;
    if (grid == 0) {
        if (n_in != 25 || out_size != S * D || ws_size < WS_END) { fprintf(stderr, "kernel_launch: unexpected shapes (n_in %d out %d ws %zu)\n", n_in, out_size, ws_size); grid = -1; return; }
        int dev = 0, cus = 0, per_cu = 0;
        if (hipGetDevice(&dev) != hipSuccess || hipDeviceGetAttribute(&cus, hipDeviceAttributeMultiprocessorCount, dev) != hipSuccess) { grid = -1; return; }
        if (hipFuncSetAttribute((const void*)fwd, hipFuncAttributeMaxDynamicSharedMemorySize, LDS_BYTES) != hipSuccess) { fprintf(stderr, "kernel_launch: hipFuncSetAttribute failed\n"); grid = -1; return; }
        if (hipOccupancyMaxActiveBlocksPerMultiprocessor(&per_cu, (const void*)fwd, NWAVES * 64, LDS_BYTES) != hipSuccess || per_cu < 1) fprintf(stderr, "kernel_launch: occupancy query says %d\n", per_cu);
        (void)hipGetLastError();
        grid = cus;
          if (grid < S / 64) { fprintf(stderr, "kernel_launch: needs >= %d CUs (one attention/LRU unit per workgroup)\n", S / 64); grid = -1; return; }
    }
    if (grid < 0) return;
    if (hipMemsetAsync((char*)d_ws + WS_CTL, 0, CTL_ZERO_BYTES, stream) != hipSuccess) return;
    Args a{};
    for (int i = 0; i < 25; ++i) a.in[i] = (const float*)d_in[i];
    a.out = (float*)d_out; a.ws = (unsigned char*)d_ws;
    for (int li = 0; li < MK_N_LAUNCHES; ++li) {
        a.ph_lo = (MK_N_LAUNCHES == 1) ? 0 : li; a.ph_hi = (MK_N_LAUNCHES == 1) ? NPHASE : li + 1; a.li = li;
        hipLaunchKernelGGL(fwd, dim3(grid), dim3(NWAVES * 64), LDS_BYTES, stream, a);
    }
#if PROBE_PHASE >= 0
    a.ph_lo = PROBE_PHASE; a.ph_hi = PROBE_PHASE + 1; a.li = 1; a.out = (float*)((unsigned char*)d_ws + WS_Y8);
    hipLaunchKernelGGL(fwd, dim3(grid), dim3(NWAVES * 64), LDS_BYTES, stream, a);
#endif
}
```
